# Optimizing an MI355X kernel written in HIP

```python
import functools
import jax, jax.numpy as jnp
from jax import lax
import numpy as np

D_MODEL = 1024
BATCH = 16
SEQ = 2048
DEPTH = 4
DEC_BATCH = 8
DEC_SEQ = 64
PAST_LEN = 4096

CHUNK = 64
H_A = 8
Q_LORA = 768
KV_LORA = 256
NOPE_DIM = 64
ROPE_DIM = 32
V_DIM = 64
ROPE_BASE = 10000.0
MLA_SCALE = (NOPE_DIM + ROPE_DIM) ** -0.5
MLA_Q_BLOCK = 128
H_B = 8
D_B = 64
LEFT_CHUNKS = 8
BAND_WINDOW = LEFT_CHUNKS * CHUNK
MAX_REL = 128
BAND_SCALE = D_B ** -0.5
D_FF = 2816
ALPHA = (2 * DEPTH) ** 0.25
BETA = (8 * DEPTH) ** -0.25
NORM_EPS = 1e-5
NEG_INF = -1e30
IN_COLS = Q_LORA + KV_LORA + ROPE_DIM + 3 * H_B * D_B + 2 * D_MODEL
IN_SPLITS = (Q_LORA,
             Q_LORA + KV_LORA,
             Q_LORA + KV_LORA + ROPE_DIM,
             Q_LORA + KV_LORA + ROPE_DIM + H_B * D_B,
             Q_LORA + KV_LORA + ROPE_DIM + 2 * H_B * D_B,
             Q_LORA + KV_LORA + ROPE_DIM + 3 * H_B * D_B,
             Q_LORA + KV_LORA + ROPE_DIM + 3 * H_B * D_B + D_MODEL)

kernel_name = "mla_chunkband_macaron_deepnorm_stream"


def layer_norm(x, g, b):
    xf = x.astype(jnp.float32)
    mu = jnp.mean(xf, axis=-1, keepdims=True)
    var = jnp.mean(jnp.square(xf - mu), axis=-1, keepdims=True)
    return ((xf - mu) * lax.rsqrt(var + NORM_EPS) * g + b).astype(x.dtype)


def rms_norm(x, g):
    xf = x.astype(jnp.float32)
    return (xf * lax.rsqrt(jnp.mean(jnp.square(xf), -1, keepdims=True) + NORM_EPS) * g).astype(x.dtype)


def rope(x, pos):
    half = ROPE_DIM // 2
    inv = ROPE_BASE ** (-jnp.arange(half, dtype=jnp.float32) / half)
    ang = pos.astype(jnp.float32)[:, None] * inv[None, :]
    cos = jnp.cos(ang)[None, :, None, :]
    sin = jnp.sin(ang)[None, :, None, :]
    x1 = x[..., :half].astype(jnp.float32)
    x2 = x[..., half:].astype(jnp.float32)
    return jnp.concatenate([x1 * cos - x2 * sin, x2 * cos + x1 * sin], axis=-1).astype(x.dtype)


def swiglu(x, w1, w2):
    a, g = jnp.split(x @ w1, 2, axis=-1)
    return (jax.nn.silu(a) * g) @ w2


def rel_bias_lookup(table, rel):
    return table[:, jnp.clip(rel, -MAX_REL, MAX_REL) + MAX_REL].astype(jnp.float32)


def mla_prompt(q_abs, q_rope, ckv, kr):
    B, S = ckv.shape[:2]
    nb = S // MLA_Q_BLOCK
    key_chunk = jnp.arange(S, dtype=jnp.int32) // CHUNK

    def block(args):
        qa, qr, qpos = args
        s = (jnp.einsum('bqhc,bkc->bhqk', qa, ckv) + jnp.einsum('bqhr,bkr->bhqk', qr, kr)).astype(jnp.float32) * MLA_SCALE
        mask = key_chunk[None, :] <= (qpos // CHUNK)[:, None]
        s = jnp.where(mask[None, None], s, NEG_INF)
        p = jax.nn.softmax(s, axis=-1).astype(ckv.dtype)
        return jnp.einsum('bhqk,bkc->bqhc', p, ckv)

    to_blocks = lambda t: jnp.moveaxis(t.reshape(B, nb, MLA_Q_BLOCK, *t.shape[2:]), 1, 0)
    qpos = jnp.arange(S, dtype=jnp.int32).reshape(nb, MLA_Q_BLOCK)
    o = lax.map(block, (to_blocks(q_abs), to_blocks(q_rope), qpos))
    return jnp.moveaxis(o, 0, 1).reshape(B, S, H_A, KV_LORA)


def mla_sample(q_abs, q_rope, ckv, kr, cache_ckv, cache_kr):
    keys_c = jnp.concatenate([cache_ckv.astype(ckv.dtype), ckv], axis=1)
    keys_r = jnp.concatenate([cache_kr.astype(kr.dtype), kr], axis=1)
    s = (jnp.einsum('bqhc,bkc->bhqk', q_abs, keys_c) + jnp.einsum('bqhr,bkr->bhqk', q_rope, keys_r)).astype(jnp.float32) * MLA_SCALE
    p = jax.nn.softmax(s, axis=-1).astype(ckv.dtype)
    return jnp.einsum('bhqk,bkc->bqhc', p, keys_c)


def band_prompt(qb, kb, vb, rel_bias):
    B, S = qb.shape[:2]
    nc = S // CHUNK
    L = LEFT_CHUNKS

    def band(t):
        tp = jnp.pad(t, ((0, 0), (L * CHUNK, 0), (0, 0), (0, 0))).reshape(B, nc + L, CHUNK, H_B, D_B)
        return jnp.concatenate([tp[:, j:j + nc] for j in range(L + 1)], axis=2)

    k_band, v_band = band(kb), band(vb)
    qc = qb.reshape(B, nc, CHUNK, H_B, D_B)
    slot = jnp.arange((L + 1) * CHUNK, dtype=jnp.int32)
    rel = L * CHUNK + jnp.arange(CHUNK, dtype=jnp.int32)[:, None] - slot[None, :]
    bias = rel_bias_lookup(rel_bias, rel)
    valid = (jnp.arange(nc, dtype=jnp.int32)[:, None] - L + slot[None, :] // CHUNK) >= 0
    s = jnp.einsum('bcqhd,bckhd->bchqk', qc, k_band).astype(jnp.float32) * BAND_SCALE + bias[None, None]
    s = jnp.where(valid[None, :, None, None, :], s, NEG_INF)
    p = jax.nn.softmax(s, axis=-1).astype(qb.dtype)
    return jnp.einsum('bchqk,bckhd->bcqhd', p, v_band).reshape(B, S, H_B * D_B)


def band_sample(qb, kb, vb, rel_bias, cache_k, cache_v):
    B, T = qb.shape[:2]
    R = cache_k.shape[1]
    k = jnp.concatenate([cache_k.astype(kb.dtype), kb], axis=1)
    v = jnp.concatenate([cache_v.astype(vb.dtype), vb], axis=1)
    q_pos = R + jnp.arange(T, dtype=jnp.int32)
    k_pos = jnp.arange(R + T, dtype=jnp.int32)
    bias = rel_bias_lookup(rel_bias, q_pos[:, None] - k_pos[None, :])
    s = jnp.einsum('bqhd,bkhd->bhqk', qb, k).astype(jnp.float32) * BAND_SCALE + bias[None]
    p = jax.nn.softmax(s, axis=-1).astype(qb.dtype)
    return jnp.einsum('bhqk,bkhd->bqhd', p, v).reshape(B, T, H_B * D_B)


def trunk_layer(x, pos, mla_fn, band_fn, w):
    (ln1_g, ln1_b, f1_w1, f1_w2, w_in, q_g, w_uq, kv_g, w_uk, w_uv, rel_bias,
     w_pa, w_pb, w_out, ln2_g, ln2_b, f2_w1, f2_w2, ln3_g, ln3_b) = w
    B, S = x.shape[:2]
    x = layer_norm(ALPHA * x + 0.5 * swiglu(x, f1_w1, f1_w2), ln1_g, ln1_b)
    z = x @ w_in
    q_lat, ckv_raw, kr_raw, qb, kb, vb, g_a, g_b = jnp.split(z, IN_SPLITS, axis=-1)
    q = (rms_norm(q_lat, q_g) @ w_uq).reshape(B, S, H_A, NOPE_DIM + ROPE_DIM)
    q_rope = rope(q[..., NOPE_DIM:], pos)
    q_abs = jnp.einsum('bshn,chn->bshc', q[..., :NOPE_DIM], w_uk.reshape(KV_LORA, H_A, NOPE_DIM))
    ckv = rms_norm(ckv_raw, kv_g)
    kr = rope(kr_raw[:, :, None, :], pos)[:, :, 0, :]
    o_lat = mla_fn(q_abs, q_rope, ckv, kr)
    o_a = jnp.einsum('bshc,chv->bshv', o_lat, w_uv.reshape(KV_LORA, H_A, V_DIM)).reshape(B, S, H_A * V_DIM)
    qb = qb.reshape(B, S, H_B, D_B)
    kb = kb.reshape(B, S, H_B, D_B)
    vb = vb.reshape(B, S, H_B, D_B)
    o_b = band_fn(qb, kb, vb, rel_bias)
    mix = (jax.nn.sigmoid(g_a) * (o_a @ w_pa) + jax.nn.sigmoid(g_b) * (o_b @ w_pb)) @ w_out
    x = layer_norm(ALPHA * x + mix, ln2_g, ln2_b)
    x = layer_norm(ALPHA * x + 0.5 * swiglu(x, f2_w1, f2_w2), ln3_g, ln3_b)
    return x, ckv, kr, kb, vb


def setup_inputs(seed: int = 0) -> dict:
    key = jax.random.key(seed)
    ks = iter(jax.random.split(key, 32))

    def nrm(shape, scale):
        return scale * jax.random.normal(next(ks), shape, jnp.float32)

    def gain(shape):
        return 1.0 + nrm(shape, 0.02)

    L, D = DEPTH, D_MODEL
    band_rows = min(BAND_WINDOW, PAST_LEN)
    return {
        "x_prompt": nrm((BATCH, SEQ, D), 1.0),
        "x_sample": nrm((DEC_BATCH, DEC_SEQ, D), 1.0),
        "cache_mla_ckv": nrm((L, DEC_BATCH, PAST_LEN, KV_LORA), 1.0),
        "cache_mla_krope": nrm((L, DEC_BATCH, PAST_LEN, ROPE_DIM), 1.0),
        "cache_band_k": nrm((L, DEC_BATCH, band_rows, H_B, D_B), 1.0),
        "cache_band_v": nrm((L, DEC_BATCH, band_rows, H_B, D_B), 1.0),
        "ln1_g": gain((L, D)),
        "ln1_b": nrm((L, D), 0.02),
        "ffn1_w1": nrm((L, D, 2 * D_FF), D ** -0.5),
        "ffn1_w2": nrm((L, D_FF, D), BETA * D_FF ** -0.5),
        "w_in": nrm((L, D, IN_COLS), D ** -0.5),
        "mla_q_norm_g": gain((L, Q_LORA)),
        "mla_w_uq": nrm((L, Q_LORA, H_A * (NOPE_DIM + ROPE_DIM)), Q_LORA ** -0.5),
        "mla_kv_norm_g": gain((L, KV_LORA)),
        "mla_w_uk": nrm((L, KV_LORA, H_A * NOPE_DIM), KV_LORA ** -0.5),
        "mla_w_uv": nrm((L, KV_LORA, H_A * V_DIM), KV_LORA ** -0.5),
        "band_rel_bias": nrm((L, H_B, 2 * MAX_REL + 1), 0.5),
        "w_proj_a": nrm((L, H_A * V_DIM, D), (H_A * V_DIM) ** -0.5),
        "w_proj_b": nrm((L, H_B * D_B, D), (H_B * D_B) ** -0.5),
        "w_out": nrm((L, D, D), BETA * D ** -0.5),
        "ln2_g": gain((L, D)),
        "ln2_b": nrm((L, D), 0.02),
        "ffn2_w1": nrm((L, D, 2 * D_FF), D ** -0.5),
        "ffn2_w2": nrm((L, D_FF, D), BETA * D_FF ** -0.5),
        "ln3_g": gain((L, D)),
        "ln3_b": nrm((L, D), 0.02),
    }


def reference(x_prompt, x_sample, cache_mla_ckv, cache_mla_krope, cache_band_k, cache_band_v,
              ln1_g, ln1_b, ffn1_w1, ffn1_w2, w_in, mla_q_norm_g, mla_w_uq, mla_kv_norm_g,
              mla_w_uk, mla_w_uv, band_rel_bias, w_proj_a, w_proj_b, w_out,
              ln2_g, ln2_b, ffn2_w1, ffn2_w2, ln3_g, ln3_b):
    S = x_prompt.shape[1]
    T = x_sample.shape[1]
    past = cache_mla_ckv.shape[2]
    pos_p = jnp.arange(S, dtype=jnp.int32)
    pos_s = past + jnp.arange(T, dtype=jnp.int32)
    band_rows_p = min(BAND_WINDOW, S)
    xp, xs = x_prompt, x_sample
    ckv_p, kr_p, kb_p, vb_p = [], [], [], []
    ckv_s, kr_s, kb_s, vb_s = [], [], [], []
    for l in range(DEPTH):
        w = (ln1_g[l], ln1_b[l], ffn1_w1[l], ffn1_w2[l], w_in[l], mla_q_norm_g[l], mla_w_uq[l],
             mla_kv_norm_g[l], mla_w_uk[l], mla_w_uv[l], band_rel_bias[l], w_proj_a[l], w_proj_b[l],
             w_out[l], ln2_g[l], ln2_b[l], ffn2_w1[l], ffn2_w2[l], ln3_g[l], ln3_b[l])
        xp, c, r, k, v = trunk_layer(xp, pos_p, mla_prompt, band_prompt, w)
        ckv_p.append(c)
        kr_p.append(r)
        kb_p.append(k[:, S - band_rows_p:])
        vb_p.append(v[:, S - band_rows_p:])
        xs, c, r, k, v = trunk_layer(
            xs, pos_s,
            functools.partial(mla_sample, cache_ckv=cache_mla_ckv[l], cache_kr=cache_mla_krope[l]),
            functools.partial(band_sample, cache_k=cache_band_k[l], cache_v=cache_band_v[l]),
            w)
        ckv_s.append(c)
        kr_s.append(r)
        kb_s.append(k)
        vb_s.append(v)
    return (xp, xs,
            jnp.stack(ckv_p), jnp.stack(kr_p), jnp.stack(kb_p), jnp.stack(vb_p),
            jnp.stack(ckv_s), jnp.stack(kr_s), jnp.stack(kb_s), jnp.stack(vb_s))
```

```cpp
#include <hip/hip_runtime.h>
#include <hip/hip_cooperative_groups.h>
#include <cstdio>
#include <cstdint>
namespace cg = cooperative_groups;
namespace pg8 {
#define PG8_LAS __attribute__((address_space(3)))
typedef unsigned short bf16_t;
typedef short bf16x8 __attribute__((ext_vector_type(8)));
typedef float f32x4 __attribute__((ext_vector_type(4)));
typedef unsigned u32x4 __attribute__((ext_vector_type(4)));
constexpr int BM = 256, BK = 64, HALF = 128, HTB = HALF * BK * 2  , STAGE_BYTES = 8 * HTB, NXCD = 8, WGM = 8;

__host__ __device__ __forceinline__ int lds_byte(int r, int c) { const int st = (r >> 4) * 2 + (c >> 5), rr = r & 15, cc = c & 31, ob = rr * 64 + cc * 2; return st * 1024 + (ob ^ (((ob >> 9) & 1) << 5)); }
__host__ __device__ __forceinline__ void stage_rc(int b, int& R, int& C) { const int st = b / 1024, sb = b % 1024, swz = sb ^ (((sb >> 9) & 1) << 5); R = (st >> 1) * 16 + swz / 64; C = (st & 1) * 32 + (swz % 64) / 2; }
__host__ __device__ __forceinline__ int perm32(int rho) { const int n = rho >> 4, i = rho & 15; return 8 * (i >> 2) + 4 * n + (i & 3); }

struct Unit { int pm, pn; };
struct Gemm { const bf16_t* A; const bf16_t* Bt; int M, N, K; };

struct StaticOrder {
    int nM, nN, nwg, G, c;
    __host__ __device__ void init(int M, int N, int G_, int c_) { nM = M / BM; nN = N / BM; nwg = nM * nN; G = G_; c = c_; }
    __host__ __device__ bool next(int i, Unit& u) const {
        const long L = (long)i * G + c; if (L >= nwg) return false;
        int wgid = (int)L; { const int q = nwg / NXCD, r = nwg % NXCD, xcd = wgid % NXCD, off = wgid / NXCD; wgid = (xcd < r ? xcd * (q + 1) : r * (q + 1) + (xcd - r) * q) + off; }
        const int nig = WGM * nN, gid = wgid / nig, fm = gid * WGM, gsz = (nM - fm) < WGM ? (nM - fm) : WGM;
        u.pm = fm + ((wgid % nig) % gsz); u.pn = (wgid % nig) / gsz; return true;
    }
    __device__ __forceinline__ void a_ready(const Unit&) const {}
    __device__ __forceinline__ void done(const Unit&) const {}
};

__device__ __forceinline__ unsigned cvt_pk_bf16(float lo, float hi) { unsigned r; asm volatile("v_cvt_pk_bf16_f32 %0, %1, %2" : "=v"(r) : "v"(lo), "v"(hi)); return r; }
typedef float f32x2 __attribute__((ext_vector_type(2)));
template <class Epi, class Sched, bool ALIGN_EPI = false, bool SP2 = false>
__device__ __forceinline__ void gemm_phase(PG8_LAS unsigned char* lds, const Gemm g, const Sched& S, const Epi& E) {
    int tid_ = threadIdx.x; asm volatile("" : "+v"(tid_)); const int tid = tid_, wid = __builtin_amdgcn_readfirstlane(tid >> 6), lane = tid & 63, wr = wid >> 2, wc = wid & 3, fr = lane & 15, fq = lane >> 4;
    int K_ = g.K; asm volatile("" : "+s"(K_)); const int K = K_, nt = K / BK;
    unsigned voffA[2], voffB[2];
#pragma unroll
    for (int i = 0; i < 2; ++i) { int R, C; stage_rc(tid * 16 + i * 8192, R, C); const int Rb = Epi::PERM ? ((R & ~31) + perm32(R & 31)) : R;
        voffA[i] = (unsigned)(R * K + C) * 2u; voffB[i] = (unsigned)(Rb * K + C) * 2u; }
    const size_t kstep = (size_t)(BK * 2);
    const size_t hstep = (size_t)HALF * K * 2;
    const size_t tstep = 2 * hstep;
    const unsigned ldsw = (unsigned)wid * 1024u;
    const int aoff = lds_byte(wr * 64 + fr, fq * 8), boff = lds_byte(wc * 32 + fr, fq * 8);
#define PG8_SA(b, h) (((b) * 2 + (h)) * HTB)
#define PG8_SB(b, h) ((4 + (b) * 2 + (h)) * HTB)
#define PG8_STAGE(bufoff, gbase, voff) do { _Pragma("unroll") for (int _i = 0; _i < 2; ++_i) \
        __builtin_amdgcn_global_load_lds((const unsigned*)((const char*)(gbase) + (voff)[_i]), (PG8_LAS unsigned*)(lds + (bufoff) + ldsw + _i * 8192), 16, 0, 0); } while (0)
#define PG8_LDA(dst, b, h) do { _Pragma("unroll") for (int m = 0; m < 4; ++m) _Pragma("unroll") for (int k = 0; k < 2; ++k) dst[m][k] = *(const PG8_LAS bf16x8*)(lds + PG8_SA(b, h) + aoff + m * 2048 + k * 1024); } while (0)
#define PG8_LDB(dst, b, h) do { _Pragma("unroll") for (int n = 0; n < 2; ++n) _Pragma("unroll") for (int k = 0; k < 2; ++k) dst[n][k] = *(const PG8_LAS bf16x8*)(lds + PG8_SB(b, h) + boff + n * 2048 + k * 1024); } while (0)
#define PG8_MMA(ai, bj, At, Bt) do { __builtin_amdgcn_s_setprio(1); _Pragma("unroll") for (int m = 0; m < 4; ++m) _Pragma("unroll") for (int n = 0; n < 2; ++n) _Pragma("unroll") for (int k = 0; k < 2; ++k) \
        acc[ai][bj][m][n] = __builtin_amdgcn_mfma_f32_16x16x32_bf16(Bt[n][k], At[m][k], acc[ai][bj][m][n], 0, 0, 0); __builtin_amdgcn_s_setprio(0); } while (0)
#define PG8_WAIT_V(n) asm volatile("s_waitcnt vmcnt(" #n ")" ::: "memory")
#define PG8_WAIT_L(n) asm volatile("s_waitcnt lgkmcnt(" #n ")" ::: "memory")
#define PG8_BAR __builtin_amdgcn_s_barrier()
#define PG8_SCHED __builtin_amdgcn_sched_barrier(0)
    Unit cur, nxt; int ui = 0;
    if (!S.next(0, cur)) return;
    f32x4 acc[2][2][4][2];
#pragma unroll
    for (int a = 0; a < 2; ++a)
#pragma unroll
        for (int b = 0; b < 2; ++b)
#pragma unroll
            for (int m = 0; m < 4; ++m)
#pragma unroll
                for (int n = 0; n < 2; ++n) acc[a][b][m][n] = (f32x4){0.f, 0.f, 0.f, 0.f};
    bf16x8 At[4][2], B0[2][2], B1[2][2];
    const char* cA = (const char*)g.A + (size_t)cur.pm * tstep; const char* cB = (const char*)g.Bt + (size_t)cur.pn * tstep;
    S.a_ready(cur);
    if constexpr (SP2) {
        PG8_STAGE(PG8_SB(0, 0), cB, voffB); PG8_STAGE(PG8_SB(0, 1), cB + hstep, voffB); PG8_STAGE(PG8_SA(0, 0), cA, voffA); PG8_STAGE(PG8_SA(0, 1), cA + hstep, voffA);
        if (wr == 1) PG8_BAR;
        PG8_WAIT_V(2); PG8_BAR;
        PG8_STAGE(PG8_SB(1, 0), cB + kstep, voffB); PG8_STAGE(PG8_SA(1, 0), cA + kstep, voffA); PG8_STAGE(PG8_SB(1, 1), cB + hstep + kstep, voffB);
        PG8_WAIT_V(6); PG8_BAR;
    } else {
        PG8_STAGE(PG8_SB(0, 0), cB, voffB); PG8_STAGE(PG8_SA(0, 0), cA, voffA); PG8_STAGE(PG8_SB(0, 1), cB + hstep, voffB); PG8_STAGE(PG8_SA(0, 1), cA + hstep, voffA);
        if (wr == 1) PG8_BAR;
        PG8_WAIT_V(4); PG8_BAR;
        PG8_STAGE(PG8_SB(1, 0), cB + kstep, voffB); PG8_STAGE(PG8_SA(1, 0), cA + kstep, voffA); PG8_STAGE(PG8_SB(1, 1), cB + hstep + kstep, voffB);
        PG8_WAIT_V(6); PG8_BAR;
    }
    for (;;) {
        const bool has_next = S.next(ui + 1, nxt);
        const char* nA = has_next ? (const char*)g.A + (size_t)nxt.pm * tstep : cA; const char* nB = has_next ? (const char*)g.Bt + (size_t)nxt.pn * tstep : cB;
        for (int t = 0; t < nt; t += 2) {
            const bool last = (t == nt - 2);
            const char* a1 = cA + (size_t)(t + 1) * kstep;
            const char* a2 = last ? nA : cA + (size_t)(t + 2) * kstep; const char* b2 = last ? nB : cB + (size_t)(t + 2) * kstep;
            const char* a3 = a2 + kstep; const char* b3 = b2 + kstep;
            if (last && has_next) S.a_ready(nxt);
            if constexpr (SP2) {
            PG8_LDB(B0, 0, 0); PG8_LDB(B1, 0, 1); PG8_SCHED; PG8_LDA(At, 0, 0); PG8_STAGE(PG8_SA(1, 1), a1 + hstep, voffA);
            PG8_WAIT_V(8); PG8_WAIT_L(0); PG8_BAR; PG8_MMA(0, 0, At, B0); PG8_MMA(0, 1, At, B1); PG8_BAR; PG8_SCHED;
            PG8_LDA(At, 0, 1); PG8_STAGE(PG8_SB(0, 0), b2, voffB); PG8_STAGE(PG8_SB(0, 1), b2 + hstep, voffB); PG8_STAGE(PG8_SA(0, 0), a2, voffA);
            PG8_WAIT_V(8); PG8_WAIT_L(0); PG8_BAR; PG8_MMA(1, 0, At, B0); PG8_MMA(1, 1, At, B1); PG8_BAR; PG8_SCHED;
            PG8_LDB(B0, 1, 0); PG8_LDB(B1, 1, 1); PG8_SCHED; PG8_LDA(At, 1, 0); PG8_STAGE(PG8_SA(0, 1), a2 + hstep, voffA);
            PG8_WAIT_V(8); PG8_WAIT_L(0); PG8_BAR; PG8_MMA(0, 0, At, B0); PG8_MMA(0, 1, At, B1); PG8_BAR; PG8_SCHED;
            PG8_LDA(At, 1, 1); PG8_STAGE(PG8_SB(1, 0), b3, voffB); PG8_STAGE(PG8_SB(1, 1), b3 + hstep, voffB); PG8_STAGE(PG8_SA(1, 0), a3, voffA);
            PG8_WAIT_V(8); PG8_WAIT_L(0); PG8_BAR; PG8_MMA(1, 0, At, B0); PG8_MMA(1, 1, At, B1); PG8_BAR; PG8_SCHED;
            } else {
            PG8_LDB(B0, 0, 0); PG8_SCHED; PG8_LDA(At, 0, 0); PG8_STAGE(PG8_SA(1, 1), a1 + hstep, voffA);
            PG8_WAIT_L(8); PG8_BAR; PG8_WAIT_L(0); PG8_MMA(0, 0, At, B0); PG8_BAR; PG8_SCHED;
            PG8_LDB(B1, 0, 1); PG8_STAGE(PG8_SB(0, 0), b2, voffB);
            PG8_BAR; PG8_WAIT_L(0); PG8_MMA(0, 1, At, B1); PG8_BAR;
            PG8_LDA(At, 0, 1); PG8_STAGE(PG8_SA(0, 0), a2, voffA);
            PG8_BAR; PG8_WAIT_L(0); PG8_MMA(1, 0, At, B0); PG8_BAR; PG8_SCHED;
            PG8_STAGE(PG8_SB(0, 1), b2 + hstep, voffB);
            PG8_WAIT_V(6); PG8_BAR; PG8_MMA(1, 1, At, B1); PG8_BAR;
            PG8_LDB(B0, 1, 0); PG8_SCHED; PG8_LDA(At, 1, 0); PG8_STAGE(PG8_SA(0, 1), a2 + hstep, voffA);
            PG8_WAIT_L(8); PG8_BAR; PG8_WAIT_L(0); PG8_MMA(0, 0, At, B0); PG8_BAR; PG8_SCHED;
            PG8_LDB(B1, 1, 1); PG8_STAGE(PG8_SB(1, 0), b3, voffB);
            PG8_BAR; PG8_WAIT_L(0); PG8_MMA(0, 1, At, B1); PG8_BAR;
            PG8_LDA(At, 1, 1); PG8_STAGE(PG8_SA(1, 0), a3, voffA);
            PG8_BAR; PG8_WAIT_L(0); PG8_MMA(1, 0, At, B0); PG8_BAR; PG8_SCHED;
            PG8_STAGE(PG8_SB(1, 1), b3 + hstep, voffB);
            PG8_WAIT_V(6); PG8_BAR; PG8_MMA(1, 1, At, B1); PG8_BAR;
            }
        }
        if constexpr (ALIGN_EPI) { if (wr == 0) PG8_BAR; }
        if constexpr (!Epi::AFTER_DRAIN) { E(acc, cur, wr, wc, fr, fq); S.done(cur); }
        if (!has_next) break;
#pragma unroll
        for (int a = 0; a < 2; ++a)
#pragma unroll
            for (int b = 0; b < 2; ++b)
#pragma unroll
                for (int m = 0; m < 4; ++m)
#pragma unroll
                    for (int n = 0; n < 2; ++n) acc[a][b][m][n] = (f32x4){0.f, 0.f, 0.f, 0.f};
        cur = nxt; cA = nA; cB = nB; ++ui;
        if constexpr (ALIGN_EPI) { if (wr == 1) PG8_BAR; }
    }
    PG8_WAIT_V(0);
    if constexpr (!ALIGN_EPI) { if (wr == 0) PG8_BAR; }
    PG8_BAR;
    if constexpr (Epi::AFTER_DRAIN) { E.fused(acc, cur, wr, wc, fr, fq, lds, wid, lane); S.done(cur); }
#undef PG8_SA
#undef PG8_SB
#undef PG8_STAGE
#undef PG8_LDA
#undef PG8_LDB
#undef PG8_MMA
#undef PG8_WAIT_V
#undef PG8_WAIT_L
#undef PG8_BAR
#undef PG8_SCHED
}
}

#define LAS __attribute__((address_space(3)))
typedef unsigned short bf16_t;
typedef short bf16x8 __attribute__((ext_vector_type(8)));
typedef short s16x4 __attribute__((ext_vector_type(4)));
typedef float f32x4 __attribute__((ext_vector_type(4)));
typedef float f32x16 __attribute__((ext_vector_type(16)));
typedef unsigned u32x4 __attribute__((ext_vector_type(4)));
typedef unsigned u32x2 __attribute__((ext_vector_type(2)));

constexpr int DEPTH = 4, MP = 32768, MS = 512, M = MP + MS, MC = 32768, MALL = M + MC;
constexpr int D = 1024, DFF = 2816, NIN = 4864, INC = 4640, MB = M + 4096;
constexpr float ALPHA = 1.681792830507429f, LOG2E = 1.4426950408889634f, EPS = 1e-5f;
constexpr float QS_MLA = 0.14724444602590306f, QS_BAND = 0.18033688011112042f;
__device__ const double INVREV[16] = {0.15915494309189535, 0.08949940160889101, 0.050329212104487035, 0.0283021958306234, 0.015915494309189534, 0.008949940160889102,
    0.005032921210448704, 0.00283021958306234, 0.0015915494309189536, 0.0008949940160889102, 0.0005032921210448703, 0.00028302195830623395, 0.00015915494309189535,
    8.949940160889102e-05, 5.0329212104487035e-05, 2.8302195830623396e-05};

constexpr size_t O_Y = 0, O_CKV_P = (size_t)M * D, O_KR_P = O_CKV_P + (size_t)DEPTH * MP * 256, O_BK_P = O_KR_P + (size_t)DEPTH * MP * 32,
    O_BV_P = O_BK_P + (size_t)DEPTH * 16 * 512 * 512, O_CKV_S = O_BV_P + (size_t)DEPTH * 16 * 512 * 512, O_KR_S = O_CKV_S + (size_t)DEPTH * MS * 256,
    O_BK_S = O_KR_S + (size_t)DEPTH * MS * 32, O_BV_S = O_BK_S + (size_t)DEPTH * MS * 512, O_END = O_BV_S + (size_t)DEPTH * MS * 512;

constexpr size_t al256(size_t x) { return (x + 255) & ~(size_t)255; }
constexpr size_t WS_CTL = 0, WS_SSQQ = 1u << 20, WS_SSQC = 3u << 20, WS_W = 4u << 20;
constexpr size_t SZ_W1 = (size_t)5632 * 1024 * 2, SZ_W2 = (size_t)1024 * 2816 * 2, SZ_WIN = (size_t)NIN * 1024 * 2, SZ_WUQ = (size_t)768 * 768 * 2, SZ_WUKV = (size_t)1024 * 256 * 2,
    SZ_WP = (size_t)1024 * 512 * 2, SZ_WO = (size_t)1024 * 1024 * 2;
constexpr size_t WS_W1A = WS_W, WS_W2A = WS_W1A + SZ_W1, WS_W1B = WS_W2A + SZ_W2, WS_W2B = WS_W1B + SZ_W1, WS_WIN = WS_W2B + SZ_W2, WS_WUQ = WS_WIN + SZ_WIN,
    WS_WUKV = WS_WUQ + SZ_WUQ, WS_WPA = WS_WUKV + SZ_WUKV, WS_WPB = WS_WPA + SZ_WP, WS_WOUT = WS_WPB + SZ_WP, WS_WEND = WS_WOUT + SZ_WO;
constexpr size_t WS_XB = al256(WS_WEND), WS_ZQ = WS_XB + (size_t)M * D * 2  , WS_CKVB = WS_ZQ + (size_t)M * 768 * 2, WS_KR = WS_CKVB + (size_t)MALL * 256 * 2,
    WS_QB = WS_KR + (size_t)MALL * 32 * 2, WS_KB = WS_QB + (size_t)M * 512 * 2, WS_VB = WS_KB + (size_t)MB * 512 * 2, WS_KNV = WS_VB + (size_t)MB * 512 * 2,
    WS_OB = WS_KNV + (size_t)MALL * 1024 * 2, WS_H = WS_OB + (size_t)M * 512 * 2, WS_GA = WS_H, WS_GB = WS_GA + (size_t)M * D * 2, WS_Q = WS_GB + (size_t)M * D * 2,
    WS_END = WS_H + (size_t)M * DFF * 2;
static_assert(WS_Q + (size_t)M * 768 * 2 == WS_END, "H overlays GA|GB|Q exactly");

__device__ __forceinline__ unsigned cvtpk(float lo, float hi) { typedef float f2 __attribute__((ext_vector_type(2))); typedef __bf16 b2 __attribute__((ext_vector_type(2)));
    f2 v = {lo, hi}; b2 b = __builtin_convertvector(v, b2); return __builtin_bit_cast(unsigned, b); }
__device__ __forceinline__ u32x4 pack8(f32x4 a, f32x4 b) { u32x4 w; w.x = cvtpk(a[0], a[1]); w.y = cvtpk(a[2], a[3]); w.z = cvtpk(b[0], b[1]); w.w = cvtpk(b[2], b[3]); return w; }
__device__ __forceinline__ float bf2f(unsigned short h) { return __uint_as_float((unsigned)h << 16); }
__device__ __forceinline__ float sigmoidf_(float x) { return __builtin_amdgcn_rcpf(1.f + __expf(-x)); }
__device__ __forceinline__ int row_pos(int m) { return m < MP ? (m & 2047) : 4096 + ((m - MP) & 63); }
__device__ __forceinline__ void rope_cs(int pos, int i, float& c, float& s) { double rev = (double)pos * INVREV[i]; rev -= floor(rev); const float r = (float)rev; s = __builtin_amdgcn_sinf(r); c = __builtin_amdgcn_cosf(r); }

using pg8::Unit;
#define EPI_ARGS const f32x4 (&acc)[2][2][4][2], const Unit& u, int wr, int wc, int fr, int fq
#define FOR_AI_M _Pragma("unroll") for (int ai = 0; ai < 2; ++ai) _Pragma("unroll") for (int m = 0; m < 4; ++m)

struct EpiSwiglu { static constexpr bool PERM = true, AFTER_DRAIN = false; bf16_t* H;
    __device__ __forceinline__ void operator()(EPI_ARGS) const {
        const int row0 = u.pm * 256 + wr * 64 + fr, col0 = u.pn * 128 + wc * 32 + 8 * fq;
        FOR_AI_M { const int row = row0 + ai * 128 + m * 16; f32x4 h0, h1;
#pragma unroll
            for (int i = 0; i < 4; ++i) { const float a = acc[ai][0][m][0][i], b = acc[ai][0][m][1][i]; h0[i] = a * sigmoidf_(a) * acc[ai][1][m][0][i]; h1[i] = b * sigmoidf_(b) * acc[ai][1][m][1][i]; }
            *(u32x4*)(H + (size_t)row * DFF + col0) = pack8(h0, h1); }
    } };
struct EpiResid { static constexpr bool PERM = true, AFTER_DRAIN = false; float* X; float s;
    __device__ __forceinline__ void operator()(EPI_ARGS) const {
        const int row0 = u.pm * 256 + wr * 64 + fr, col0 = u.pn * 256 + wc * 32 + 8 * fq;
        FOR_AI_M { float* xp = X + (size_t)(row0 + ai * 128 + m * 16) * D + col0;
#pragma unroll
            for (int bj = 0; bj < 2; ++bj)
#pragma unroll
                for (int n = 0; n < 2; ++n) { f32x4* p = (f32x4*)(xp + bj * 128 + 4 * n); *p = *p * ALPHA + acc[ai][bj][m][n] * s; } }
    } };
struct EpiPlain { static constexpr bool PERM = true, AFTER_DRAIN = false; bf16_t* O; int ldc;
    __device__ __forceinline__ void operator()(EPI_ARGS) const {
        const int row0 = u.pm * 256 + wr * 64 + fr, col0 = u.pn * 256 + wc * 32 + 8 * fq;
        FOR_AI_M { bf16_t* op = O + (size_t)(row0 + ai * 128 + m * 16) * ldc + col0;
#pragma unroll
            for (int bj = 0; bj < 2; ++bj) *(u32x4*)(op + bj * 128) = pack8(acc[ai][bj][m][0], acc[ai][bj][m][1]); }
    } };
template <int MODE> struct EpiGate { static constexpr bool PERM = true, AFTER_DRAIN = false; bf16_t* T; const bf16_t* G;
    __device__ __forceinline__ void operator()(EPI_ARGS) const {
        const int row0 = u.pm * 256 + wr * 64 + fr, col0 = u.pn * 256 + wc * 32 + 8 * fq;
        FOR_AI_M { const size_t off = (size_t)(row0 + ai * 128 + m * 16) * D + col0;
#pragma unroll
            for (int bj = 0; bj < 2; ++bj) { const bf16x8 t = *(const bf16x8*)(T + off + bj * 128); f32x4 r0, r1;
                if (MODE == 0) {
#pragma unroll
                    for (int i = 0; i < 4; ++i) { r0[i] = bf2f((unsigned short)t[i]) * acc[ai][bj][m][0][i]; r1[i] = bf2f((unsigned short)t[4 + i]) * acc[ai][bj][m][1][i]; }
                } else { const bf16x8 g = *(const bf16x8*)(G + off + bj * 128);
#pragma unroll
                    for (int i = 0; i < 4; ++i) { r0[i] = bf2f((unsigned short)t[i]) + bf2f((unsigned short)g[i]) * acc[ai][bj][m][0][i]; r1[i] = bf2f((unsigned short)t[4 + i]) + bf2f((unsigned short)g[4 + i]) * acc[ai][bj][m][1][i]; }
                }
                *(u32x4*)(T + off + bj * 128) = pack8(r0, r1); } }
    } };
struct EpiWin { static constexpr bool PERM = true, AFTER_DRAIN = false;
    bf16_t *ZQ, *KR, *QB, *KB, *VB, *GA, *GB; float *ssq_q, *ssq_c, *out; int layer;
    __device__ __forceinline__ void operator()(EPI_ARGS) const {
        const int pn = u.pn, row0 = u.pm * 256 + wr * 64 + fr, cw = wc * 32 + 8 * fq;
        const bool samp = u.pm >= 128;
        if (pn < 3) {
            FOR_AI_M { const int row = row0 + ai * 128 + m * 16; float ss = 0.f;
#pragma unroll
                for (int bj = 0; bj < 2; ++bj) { const f32x4 a = acc[ai][bj][m][0], b = acc[ai][bj][m][1]; ss += (a[0] * a[0] + a[1] * a[1]) + (a[2] * a[2] + a[3] * a[3]) + (b[0] * b[0] + b[1] * b[1]) + (b[2] * b[2] + b[3] * b[3]);
                    *(u32x4*)(ZQ + (size_t)row * 768 + pn * 256 + bj * 128 + cw) = pack8(a, b); }
                ss += __shfl_xor(ss, 16); ss += __shfl_xor(ss, 32);
                if (fq == 0) ssq_q[(size_t)row * 12 + pn * 4 + wc] = ss; }
        } else if (pn == 3) {
            FOR_AI_M { const int row = row0 + ai * 128 + m * 16; float ss = 0.f;
                float* op = samp ? out + O_CKV_S + ((size_t)layer * MS + (row - MP)) * 256 : out + O_CKV_P + ((size_t)layer * MP + row) * 256;
#pragma unroll
                for (int bj = 0; bj < 2; ++bj) { const f32x4 a = acc[ai][bj][m][0], b = acc[ai][bj][m][1]; ss += (a[0] * a[0] + a[1] * a[1]) + (a[2] * a[2] + a[3] * a[3]) + (b[0] * b[0] + b[1] * b[1]) + (b[2] * b[2] + b[3] * b[3]);
                    *(f32x4*)(op + bj * 128 + cw) = a; *(f32x4*)(op + bj * 128 + cw + 4) = b; }
                ss += __shfl_xor(ss, 16); ss += __shfl_xor(ss, 32);
                if (fq == 0) ssq_c[(size_t)row * 4 + wc] = ss; }
        } else if (pn == 4) {
            if (wc == 0) {
                FOR_AI_M { const int row = row0 + ai * 128 + m * 16, pos = row_pos(row);
                    float* op = samp ? out + O_KR_S + ((size_t)layer * MS + (row - MP)) * 32 : out + O_KR_P + ((size_t)layer * MP + row) * 32;
                    const f32x4 a = acc[ai][0][m][0], b = acc[ai][0][m][1]; const float v[8] = {a[0], a[1], a[2], a[3], b[0], b[1], b[2], b[3]}; float r[8];
#pragma unroll
                    for (int j = 0; j < 4; ++j) { const int i = 4 * fq + j; float c, s; rope_cs(pos, i, c, s); const float x1 = v[2 * j], x2 = v[2 * j + 1];
                        r[2 * j] = x1 * c - x2 * s; r[2 * j + 1] = x2 * c + x1 * s; op[i] = r[2 * j]; op[16 + i] = r[2 * j + 1]; }
                    *(u32x4*)(KR + (size_t)row * 32 + 8 * fq) = pack8((f32x4){r[0], r[1], r[2], r[3]}, (f32x4){r[4], r[5], r[6], r[7]}); }
            }
        } else if (pn < 7) {
            FOR_AI_M { const int row = row0 + ai * 128 + m * 16;
#pragma unroll
                for (int bj = 0; bj < 2; ++bj) *(u32x4*)(QB + (size_t)row * 512 + (pn - 5) * 256 + bj * 128 + cw) = pack8(acc[ai][bj][m][0] * QS_BAND, acc[ai][bj][m][1] * QS_BAND); }
        } else if (pn < 11) {
            const bool isv = pn >= 9; bf16_t* B = isv ? VB : KB; const int c0 = ((pn - 7) & 1) * 256 + cw;
            const bool wout = samp || ((u.pm & 7) >= 6);
            FOR_AI_M { const int row = row0 + ai * 128 + m * 16;
                float* op = samp ? out + (isv ? O_BV_S : O_BK_S) + ((size_t)layer * MS + (row - MP)) * 512
                                 : out + (isv ? O_BV_P : O_BK_P) + (((size_t)layer * 16 + (row >> 11)) * 512 + ((row & 2047) - 1536)) * 512;
#pragma unroll
                for (int bj = 0; bj < 2; ++bj) { const f32x4 a = acc[ai][bj][m][0], b = acc[ai][bj][m][1];
                    *(u32x4*)(B + (size_t)row * 512 + c0 + bj * 128) = pack8(a, b);
                    if (wout) { *(f32x4*)(op + c0 + bj * 128) = a; *(f32x4*)(op + c0 + bj * 128 + 4) = b; } } }
        } else {
            bf16_t* G = pn < 15 ? GA : GB; const int c0 = ((pn - 11) & 3) * 256 + cw;
            FOR_AI_M { const int row = row0 + ai * 128 + m * 16;
#pragma unroll
                for (int bj = 0; bj < 2; ++bj) { f32x4 a = acc[ai][bj][m][0], b = acc[ai][bj][m][1];
#pragma unroll
                    for (int i = 0; i < 4; ++i) { a[i] = sigmoidf_(a[i]); b[i] = sigmoidf_(b[i]); }
                    *(u32x4*)(G + (size_t)row * D + c0 + bj * 128) = pack8(a, b); } }
        }
    } };
struct EpiQ { static constexpr bool PERM = true, AFTER_DRAIN = false; bf16_t* Q; const float* ssq_q;
    __device__ __forceinline__ void operator()(EPI_ARGS) const {
        const int row0 = u.pm * 256 + wr * 64 + fr, col0 = u.pn * 256 + wc * 32 + 8 * fq;
        FOR_AI_M { const int row = row0 + ai * 128 + m * 16; const f32x4* sp = (const f32x4*)(ssq_q + (size_t)row * 12);
            const f32x4 s0 = sp[0], s1 = sp[1], s2 = sp[2];
            const float ss = ((s0[0] + s0[1]) + (s0[2] + s0[3])) + ((s1[0] + s1[1]) + (s1[2] + s1[3])) + ((s2[0] + s2[1]) + (s2[2] + s2[3]));
            const float sc = QS_MLA * __builtin_amdgcn_rsqf(ss * (1.0f / 768.0f) + EPS);
#pragma unroll
            for (int bj = 0; bj < 2; ++bj) { f32x4 a = acc[ai][bj][m][0] * sc, b = acc[ai][bj][m][1] * sc;
                const int cb = 8 * u.pn + 4 * bj + wc;
                if (cb % 3 == 2) { const int pos = row_pos(row); const float v[8] = {a[0], a[1], a[2], a[3], b[0], b[1], b[2], b[3]}; float r[8];
#pragma unroll
                    for (int j = 0; j < 4; ++j) { float c, s; rope_cs(pos, 4 * fq + j, c, s); r[2 * j] = v[2 * j] * c - v[2 * j + 1] * s; r[2 * j + 1] = v[2 * j + 1] * c + v[2 * j] * s; }
                    a = (f32x4){r[0], r[1], r[2], r[3]}; b = (f32x4){r[4], r[5], r[6], r[7]}; }
                *(u32x4*)(Q + (size_t)row * 768 + col0 + bj * 128) = pack8(a, b); } }
    } };

#define LDS_WAIT() asm volatile("s_waitcnt lgkmcnt(0)" ::: "memory")
__device__ __forceinline__ void t_item(const float* src, int ldn, int K, int k0, int cbase, bool ilv, const float* kscale, bf16_t* dst, int n0, LAS float* scr, int lane) {
    const int c = lane & 7;
    if (cbase < 0) {
#pragma unroll
        for (int j = 0; j < 4; ++j) { const int n = (lane >> 3) + 8 * j; *(u32x4*)(dst + (size_t)(n0 + n) * K + k0 + 8 * c) = (u32x4){0u, 0u, 0u, 0u}; }
        return;
    }
#pragma unroll 8
    for (int i = 0; i < 32; ++i) { const int kk = 2 * i + (lane >> 5); float v = src[(size_t)(k0 + kk) * ldn + cbase + (lane & 31)]; if (kscale) v *= kscale[k0 + kk]; scr[kk * 33 + (lane & 31)] = v; }
    LDS_WAIT(); asm volatile("" ::: "memory");
#pragma unroll
    for (int j = 0; j < 4; ++j) { const int n = (lane >> 3) + 8 * j; const int sc = ilv ? ((n >> 1) + 16 * (n & 1)) : n; const LAS float* s = scr + (8 * c) * 33 + sc;
        u32x4 o; o.x = cvtpk(s[0 * 33], s[1 * 33]); o.y = cvtpk(s[2 * 33], s[3 * 33]); o.z = cvtpk(s[4 * 33], s[5 * 33]); o.w = cvtpk(s[6 * 33], s[7 * 33]);
        *(u32x4*)(dst + (size_t)(n0 + n) * K + k0 + 8 * c) = o; }
    LDS_WAIT(); asm volatile("" ::: "memory");
}
struct Params { const float* in[26]; float* out; unsigned char* ws; };

__device__ __forceinline__ void convert_phase(const Params& P, int l, LAS unsigned char* lds, int G) {
    int tid_ = threadIdx.x; asm volatile("" : "+v"(tid_)); const int tid = tid_, lane = tid & 63, wave = tid >> 6;
    LAS float* scr = (LAS float*)(lds + wave * 8448);
    const int gw = blockIdx.x * 8 + wave, NGW = G * 8;
    unsigned char* ws = P.ws;
    constexpr int I_W1 = 16 * 176, I_W2 = 44 * 32, I_WIN = 16 * 152, I_WUQ = 12 * 24, I_WUK = 4 * 16, I_WP = 8 * 32, I_WO = 16 * 32;
    constexpr int NITEMS = 2 * (I_W1 + I_W2) + I_WIN + I_WUQ + 2 * I_WUK + 2 * I_WP + I_WO;
    for (int it = gw; it < NITEMS; it += NGW) {
        int r = it;
#pragma unroll
        for (int f = 0; f < 2; ++f) {
            if (r >= 0 && r < I_W1) { const int kb = r / 176, nb = r % 176, n0 = nb * 32, t = n0 >> 8, j = n0 & 255; const int cb = j < 128 ? 128 * t + j : DFF + 128 * t + (j - 128);
                t_item(P.in[f ? 22 : 8] + (size_t)l * 1024 * 5632, 5632, 1024, kb * 64, cb, false, nullptr, (bf16_t*)(ws + (f ? WS_W1B : WS_W1A)), n0, scr, lane); r = -1; }
            if (r >= 0) r -= I_W1;
            if (r >= 0 && r < I_W2) { const int kb = r / 32, nb = r % 32;
                t_item(P.in[f ? 23 : 9] + (size_t)l * 2816 * 1024, 1024, 2816, kb * 64, nb * 32, false, nullptr, (bf16_t*)(ws + (f ? WS_W2B : WS_W2A)), nb * 32, scr, lane); r = -1; }
            if (r >= 0) r -= I_W2;
        }
        if (r < 0) continue;
        if (r < I_WIN) { const int kb = r / 152, nb = r % 152, n0 = nb * 32; int cb; bool il = false;
            if (n0 < 1024) cb = n0; else if (n0 == 1024) { cb = 1024; il = true; } else if (n0 < 1280) cb = -1; else cb = n0 - 1280 + 1056;
            t_item(P.in[10] + (size_t)l * 1024 * INC, INC, 1024, kb * 64, cb, il, nullptr, (bf16_t*)(ws + WS_WIN), n0, scr, lane); continue; } r -= I_WIN;
        if (r < I_WUQ) { const int kb = r / 24, nb = r % 24;
            t_item(P.in[12] + (size_t)l * 768 * 768, 768, 768, kb * 64, nb * 32, (nb % 3) == 2, P.in[11] + l * 768, (bf16_t*)(ws + WS_WUQ), nb * 32, scr, lane); continue; } r -= I_WUQ;
        if (r < I_WUK) { const int kb = r / 16, nb = r % 16; t_item(P.in[14] + (size_t)l * 256 * 512, 512, 256, kb * 64, nb * 32, false, nullptr, (bf16_t*)(ws + WS_WUKV), nb * 32, scr, lane); continue; } r -= I_WUK;
        if (r < I_WUK) { const int kb = r / 16, nb = r % 16; t_item(P.in[15] + (size_t)l * 256 * 512, 512, 256, kb * 64, nb * 32, false, nullptr, (bf16_t*)(ws + WS_WUKV), 512 + nb * 32, scr, lane); continue; } r -= I_WUK;
        if (r < I_WP) { const int kb = r / 32, nb = r % 32; t_item(P.in[17] + (size_t)l * 512 * 1024, 1024, 512, kb * 64, nb * 32, false, nullptr, (bf16_t*)(ws + WS_WPA), nb * 32, scr, lane); continue; } r -= I_WP;
        if (r < I_WP) { const int kb = r / 32, nb = r % 32; t_item(P.in[18] + (size_t)l * 512 * 1024, 1024, 512, kb * 64, nb * 32, false, nullptr, (bf16_t*)(ws + WS_WPB), nb * 32, scr, lane); continue; } r -= I_WP;
        { const int kb = r / 32, nb = r % 32; t_item(P.in[19] + (size_t)l * 1024 * 1024, 1024, 1024, kb * 64, nb * 32, false, nullptr, (bf16_t*)(ws + WS_WOUT), nb * 32, scr, lane); }
    }
    const size_t gt = (size_t)blockIdx.x * 512 + tid, NT = (size_t)G * 512;
    { const f32x4* s = (const f32x4*)(P.in[2] + (size_t)l * MC * 256); u32x2* d = (u32x2*)((bf16_t*)(ws + WS_CKVB) + (size_t)M * 256);
      for (size_t i = gt; i < (size_t)MC * 64; i += NT) { const f32x4 v = s[i]; d[i] = (u32x2){cvtpk(v[0], v[1]), cvtpk(v[2], v[3])}; } }
    { const f32x4* s = (const f32x4*)(P.in[4] + (size_t)l * 4096 * 512); u32x2* d = (u32x2*)((bf16_t*)(ws + WS_KB) + (size_t)M * 512);
      for (size_t i = gt; i < (size_t)4096 * 128; i += NT) { const f32x4 v = s[i]; d[i] = (u32x2){cvtpk(v[0], v[1]), cvtpk(v[2], v[3])}; } }
    { const f32x4* s = (const f32x4*)(P.in[5] + (size_t)l * 4096 * 512); u32x2* d = (u32x2*)((bf16_t*)(ws + WS_VB) + (size_t)M * 512);
      for (size_t i = gt; i < (size_t)4096 * 128; i += NT) { const f32x4 v = s[i]; d[i] = (u32x2){cvtpk(v[0], v[1]), cvtpk(v[2], v[3])}; } }
    { const float* s = P.in[3] + (size_t)l * MC * 32; bf16_t* d = (bf16_t*)(ws + WS_KR) + (size_t)M * 32;
      for (size_t i = gt; i < (size_t)MC * 4; i += NT) { const size_t row = i >> 2; const int c = (int)(i & 3); const f32x4 a = *(const f32x4*)(s + row * 32 + 4 * c), b = *(const f32x4*)(s + row * 32 + 16 + 4 * c);
          *(u32x4*)(d + row * 32 + 8 * c) = (u32x4){cvtpk(a[0], b[0]), cvtpk(a[1], b[1]), cvtpk(a[2], b[2]), cvtpk(a[3], b[3])}; } }
    if (l == 0) {
        f32x4* X = (f32x4*)P.out; u32x2* XB = (u32x2*)(ws + WS_XB); const f32x4* xp = (const f32x4*)P.in[0]; const f32x4* xs = (const f32x4*)P.in[1];
        for (size_t i = gt; i < (size_t)M * 256; i += NT) { const f32x4 v = i < (size_t)MP * 256 ? xp[i] : xs[i - (size_t)MP * 256]; X[i] = v; XB[i] = (u32x2){cvtpk(v[0], v[1]), cvtpk(v[2], v[3])}; }
    }
}

__device__ __forceinline__ float wave_sum(float v) {
#pragma unroll
    for (int o = 1; o < 64; o <<= 1) v += __shfl_xor(v, o);
    return v;
}
__device__ __forceinline__ void ln_phase(float* X, bf16_t* XB, const float* g, const float* b, int G) {
    int tid_ = threadIdx.x; asm volatile("" : "+v"(tid_)); const int lane = tid_ & 63, gw = blockIdx.x * 8 + (tid_ >> 6), NGW = G * 8;
    f32x4 gv[4], bv[4];
#pragma unroll
    for (int j = 0; j < 4; ++j) { gv[j] = ((const f32x4*)g)[lane + 64 * j]; bv[j] = ((const f32x4*)b)[lane + 64 * j]; }
    for (int m = gw; m < M; m += NGW) {
        f32x4* xr = (f32x4*)(X + (size_t)m * D) + lane; f32x4 v[4]; float s = 0.f;
#pragma unroll
        for (int j = 0; j < 4; ++j) { v[j] = xr[64 * j]; s += (v[j][0] + v[j][1]) + (v[j][2] + v[j][3]); }
        const float mean = wave_sum(s) * (1.f / D); float s2 = 0.f;
#pragma unroll
        for (int j = 0; j < 4; ++j) { v[j] = v[j] - mean; s2 += (v[j][0] * v[j][0] + v[j][1] * v[j][1]) + (v[j][2] * v[j][2] + v[j][3] * v[j][3]); }
        const float rstd = 1.f / sqrtf(wave_sum(s2) * (1.f / D) + EPS);
        u32x2* o8 = (u32x2*)(XB + (size_t)m * D) + lane;
#pragma unroll
        for (int j = 0; j < 4; ++j) { const f32x4 y = v[j] * rstd * gv[j] + bv[j]; xr[64 * j] = y; o8[64 * j] = (u32x2){cvtpk(y[0], y[1]), cvtpk(y[2], y[3])}; }
    }
}
__device__ __forceinline__ void ckv_phase(float* out, int l, const float* ssq_c, const float* g, bf16_t* CKVB, int G) {
    int tid_ = threadIdx.x; asm volatile("" : "+v"(tid_)); const int lane = tid_ & 63, gw = blockIdx.x * 8 + (tid_ >> 6), NGW = G * 8;
    const f32x4 gv = ((const f32x4*)g)[lane];
    for (int m = gw; m < M; m += NGW) {
        float* op = m >= MP ? out + O_CKV_S + ((size_t)l * MS + (m - MP)) * 256 : out + O_CKV_P + ((size_t)l * MP + m) * 256;
        const f32x4 sp = *(const f32x4*)(ssq_c + (size_t)m * 4); const float rstd = __builtin_amdgcn_rsqf(((sp[0] + sp[1]) + (sp[2] + sp[3])) * (1.f / 256.f) + EPS);
        f32x4 v = ((f32x4*)op)[lane]; v = v * rstd * gv; ((f32x4*)op)[lane] = v;
        ((u32x2*)(CKVB + (size_t)m * 256))[lane] = (u32x2){cvtpk(v[0], v[1]), cvtpk(v[2], v[3])};
    }
}

namespace att {
constexpr int KSTR = 208, L_K = 0, L_V = 2 * 64 * KSTR, L_TAB = L_V + 2 * 8192, L_Q = L_TAB + 1040, L_END = L_Q + 16;
struct Desc { int type, h, qrow0, nqc, c0, t_lo, t_hi, tc, cbase, nbase; };
__device__ __forceinline__ int crow(int r, int hi) { return (r & 3) + 8 * (r >> 2) + 4 * hi; }
__device__ __forceinline__ float xmax(float m) { auto rr = __builtin_amdgcn_permlane32_swap(__float_as_uint(m), __float_as_uint(m), false, false); return fmaxf(__uint_as_float(rr[0]), __uint_as_float(rr[1])); }
__device__ __forceinline__ float xsum(float m) { auto rr = __builtin_amdgcn_permlane32_swap(__float_as_uint(m), __float_as_uint(m), false, false); return __uint_as_float(rr[0]) + __uint_as_float(rr[1]); }
typedef short v4i16_t __attribute__((ext_vector_type(4)));
__device__ __forceinline__ s16x4 vtr(const LAS unsigned char* p) { return __builtin_bit_cast(s16x4, __builtin_amdgcn_ds_read_tr16_b64_v4i16((LAS v4i16_t*)p)); }

template <int TYPE>
__device__ __forceinline__ void unit(const Desc u, const bf16_t* Qp, int qld, const bf16_t* Kp, int kld, const bf16_t* Vp, int vld, const bf16_t* KRp, const float* tab_g, bf16_t* Op, LAS unsigned char* lds) {
    constexpr int NS = TYPE == 0 ? 6 : 4;
    int tid_ = threadIdx.x; asm volatile("" : "+v"(tid_)); const int tid = tid_, lane = tid & 63, w = __builtin_amdgcn_readfirstlane(tid >> 6), r32 = lane & 31, hi = lane >> 5;
    const bool wact = (w >> 1) < u.nqc; const int cw = u.c0 + (w >> 1);
    const int skey = tid >> 3, sch = tid & 7, rkey = (tid >> 2) & 63, rch = tid & 3;
    LAS float* tab = (LAS float*)(lds + L_TAB);
    if (TYPE == 1) { for (int i = tid; i < 257; i += 512) tab[i] = tab_g[i] * LOG2E; }
    const int qrow = u.qrow0 + 32 * w + r32;
    bf16x8 qf[NS];
    if (wact) {
#pragma unroll
        for (int s = 0; s < NS; ++s) qf[s] = *(const bf16x8*)(Qp + (size_t)qrow * qld + 16 * s + 8 * hi);
    }
    u32x4 kreg, vreg, rreg = (u32x4){0u, 0u, 0u, 0u};
#define ATT_LOADG(t) do { const int row_ = ((t) < u.tc) ? u.cbase + 64 * (t) : u.nbase + 64 * ((t) - u.tc); \
        kreg = *(const u32x4*)(Kp + (size_t)(row_ + skey) * kld + sch * 8); vreg = *(const u32x4*)(Vp + (size_t)(row_ + skey) * vld + sch * 8); \
        if (TYPE == 0 && tid < 256) rreg = *(const u32x4*)(KRp + (size_t)(row_ + rkey) * 32 + rch * 8); } while (0)
#define ATT_STOREL(b) do { *(LAS u32x4*)(lds + L_K + (b) * 64 * KSTR + skey * KSTR + sch * 16) = kreg; \
        *(LAS u32x4*)(lds + L_V + (b) * 8192 + ((skey >> 3) * 2 + (sch >> 2)) * 512 + (skey & 7) * 64 + (sch & 3) * 16) = vreg; \
        if (TYPE == 0 && tid < 256) *(LAS u32x4*)(lds + L_K + (b) * 64 * KSTR + rkey * KSTR + 128 + rch * 16) = rreg; } while (0)
    float m_run = -1e30f, l_run = 0.f; f32x16 o0 = {}, o1 = {};
    const int vlane = (4 * hi + ((lane >> 2) & 3)) * 64 + ((lane >> 4) & 1) * 32 + (lane & 3) * 8;
    ATT_LOADG(u.t_lo); ATT_STOREL(0); __syncthreads();
    for (int t = u.t_lo; t <= u.t_hi; ++t) {
        const int buf = (t - u.t_lo) & 1;
        if (t < u.t_hi) ATT_LOADG(t + 1);
        if (wact && t <= cw && (TYPE == 0 || t >= cw - 8)) {
            const LAS unsigned char* Kb = lds + L_K + buf * 64 * KSTR + r32 * KSTR + hi * 16;
            f32x16 p0 = {}, p1 = {};
#pragma unroll
            for (int s = 0; s < NS; ++s) { const bf16x8 k0 = *(const LAS bf16x8*)(Kb + s * 32), k1 = *(const LAS bf16x8*)(Kb + 32 * KSTR + s * 32);
                p0 = __builtin_amdgcn_mfma_f32_32x32x16_bf16(k0, qf[s], p0, 0, 0, 0); p1 = __builtin_amdgcn_mfma_f32_32x32x16_bf16(k1, qf[s], p1, 0, 0, 0); }
            if (TYPE == 1) { const int dc = cw - t;
                if (dc >= 3) { const float c = tab[256];
#pragma unroll
                    for (int r = 0; r < 16; ++r) { p0[r] += c; p1[r] += c; } }
                else { const int base = dc * 64 + (w & 1) * 32 + r32 + 128;
#pragma unroll
                    for (int r = 0; r < 16; ++r) { const int i0 = base - crow(r, hi), i1 = i0 - 32; p0[r] += tab[min(max(i0, 0), 256)]; p1[r] += tab[min(max(i1, 0), 256)]; } } }
            float mx = fmaxf(p0[0], p1[0]);
#pragma unroll
            for (int r = 1; r < 16; ++r) mx = fmaxf(mx, fmaxf(p0[r], p1[r]));
            mx = xmax(mx);
            const float mn = fmaxf(m_run, mx), alpha = __builtin_amdgcn_exp2f(m_run - mn); m_run = mn;
            float sum = 0.f;
#pragma unroll
            for (int r = 0; r < 16; ++r) { p0[r] = __builtin_amdgcn_exp2f(p0[r] - mn); p1[r] = __builtin_amdgcn_exp2f(p1[r] - mn); sum += p0[r] + p1[r]; }
            l_run = l_run * alpha + sum;
#pragma unroll
            for (int r = 0; r < 16; ++r) { o0[r] *= alpha; o1[r] *= alpha; }
            bf16x8 pf[2][2];
#pragma unroll
            for (int a = 0; a < 2; ++a) {
                pf[0][a] = __builtin_bit_cast(bf16x8, (u32x4){cvtpk(p0[8 * a], p0[8 * a + 1]), cvtpk(p0[8 * a + 2], p0[8 * a + 3]), cvtpk(p0[8 * a + 4], p0[8 * a + 5]), cvtpk(p0[8 * a + 6], p0[8 * a + 7])});
                pf[1][a] = __builtin_bit_cast(bf16x8, (u32x4){cvtpk(p1[8 * a], p1[8 * a + 1]), cvtpk(p1[8 * a + 2], p1[8 * a + 3]), cvtpk(p1[8 * a + 4], p1[8 * a + 5]), cvtpk(p1[8 * a + 6], p1[8 * a + 7])}); }
            const LAS unsigned char* Vb = lds + L_V + buf * 8192 + vlane;
#pragma unroll
            for (int kh = 0; kh < 2; ++kh)
#pragma unroll
                for (int a = 0; a < 2; ++a) {
                    { const s16x4 lo = vtr(Vb + (8 * kh + 4 * a) * 512), h4 = vtr(Vb + (8 * kh + 4 * a) * 512 + 1024);
                      const bf16x8 vf = (bf16x8){lo[0], lo[1], lo[2], lo[3], h4[0], h4[1], h4[2], h4[3]}; o0 = __builtin_amdgcn_mfma_f32_32x32x16_bf16(vf, pf[kh][a], o0, 0, 0, 0); }
                    { const s16x4 lo = vtr(Vb + (8 * kh + 4 * a + 1) * 512), h4 = vtr(Vb + (8 * kh + 4 * a + 1) * 512 + 1024);
                      const bf16x8 vf = (bf16x8){lo[0], lo[1], lo[2], lo[3], h4[0], h4[1], h4[2], h4[3]}; o1 = __builtin_amdgcn_mfma_f32_32x32x16_bf16(vf, pf[kh][a], o1, 0, 0, 0); }
                }
        }
        if (t < u.t_hi) ATT_STOREL(buf ^ 1);
        __syncthreads();
    }
    if (wact) {
        const float inv = 1.0f / xsum(l_run);
        bf16_t* op = Op + (size_t)qrow * 512;
#pragma unroll
        for (int g = 0; g < 4; ++g) {
            *(u32x2*)(op + 8 * g + 4 * hi) = (u32x2){cvtpk(o0[4 * g] * inv, o0[4 * g + 1] * inv), cvtpk(o0[4 * g + 2] * inv, o0[4 * g + 3] * inv)};
            *(u32x2*)(op + 32 + 8 * g + 4 * hi) = (u32x2){cvtpk(o1[4 * g] * inv, o1[4 * g + 1] * inv), cvtpk(o1[4 * g + 2] * inv, o1[4 * g + 3] * inv)}; }
    }
#undef ATT_LOADG
#undef ATT_STOREL
}

constexpr int NU_SM = 64, NU_A = 640, NU_B = 768, NU_C = 128, NU_D = 64, NU_E = 512, NUNITS = NU_SM + NU_A + NU_B + NU_C + NU_D + NU_E;
__device__ __forceinline__ Desc decode(int idx) {
    Desc d; int type, b, h, qb = 0; bool samp = false;
    if (idx < NU_SM) { type = 0; samp = true; b = idx >> 3; h = idx & 7; }
    else { idx -= NU_SM;
        if (idx < NU_A) { type = 0; qb = 7 - idx / 128; b = (idx % 128) >> 3; h = idx & 7; }
        else { idx -= NU_A;
            if (idx < NU_B) { type = 1; qb = 7 - idx / 128; b = (idx % 128) >> 3; h = idx & 7; }
            else { idx -= NU_B;
                if (idx < NU_C) { type = 0; qb = 2; b = idx >> 3; h = idx & 7; }
                else { idx -= NU_C;
                    if (idx < NU_D) { type = 1; samp = true; b = idx >> 3; h = idx & 7; }
                    else { idx -= NU_D; const int s = idx / 128; type = (s & 1) ? 0 : 1; qb = s < 2 ? 1 : 0; b = (idx % 128) >> 3; h = idx & 7; } } } } }
    d.type = type; d.h = h;
    if (samp) { d.qrow0 = MP + 64 * b; d.nqc = 1; d.t_lo = 0; d.nbase = MP + 64 * b;
        if (type == 0) { d.c0 = 64; d.t_hi = 64; d.tc = 64; d.cbase = M + 4096 * b; } else { d.c0 = 8; d.t_hi = 8; d.tc = 8; d.cbase = M + 512 * b; } }
    else { d.qrow0 = b * 2048 + 256 * qb; d.nqc = 4; d.c0 = 4 * qb; d.t_hi = 4 * qb + 3; d.tc = 0; d.cbase = 0; d.nbase = b * 2048; d.t_lo = type == 0 ? 0 : max(0, 4 * qb - 8); }
    return d;
}
__device__ __forceinline__ void phase(unsigned char* ws, const float* relb  , unsigned* ctr, LAS unsigned char* lds) {
    int tid_ = threadIdx.x; asm volatile("" : "+v"(tid_)); const int tid = tid_; LAS int* sq = (LAS int*)(lds + L_Q);
    const bf16_t* Q = (const bf16_t*)(ws + WS_Q); const bf16_t* KNV = (const bf16_t*)(ws + WS_KNV); const bf16_t* KR = (const bf16_t*)(ws + WS_KR);
    const bf16_t* QB = (const bf16_t*)(ws + WS_QB); const bf16_t* KB = (const bf16_t*)(ws + WS_KB); const bf16_t* VB = (const bf16_t*)(ws + WS_VB);
    bf16_t* OA = (bf16_t*)(ws + WS_ZQ); bf16_t* OB = (bf16_t*)(ws + WS_OB);
    for (;;) {
        if (tid == 0) *sq = (int)atomicAdd(ctr, 1u);
        __syncthreads(); const int idx = __builtin_amdgcn_readfirstlane(*sq); __syncthreads();
        if (idx >= NUNITS) break;
        const Desc d = decode(idx);
        if (d.type == 0) unit<0>(d, Q + d.h * 96, 768, KNV + d.h * 64, 1024, KNV + 512 + d.h * 64, 1024, KR, nullptr, OA + d.h * 64, lds);
        else unit<1>(d, QB + d.h * 64, 512, KB + d.h * 64, 512, VB + d.h * 64, 512, nullptr, relb + d.h * 257, OB + d.h * 64, lds);
    }
}
}
#ifndef PHMASK
#define PHMASK 0xFFFFFF
#endif

constexpr int LDS_BYTES = 147456;
#define PH_GEMM(EPI, ALIGN, Aptr, Bptr, Mrows, N, K, ...) do { pg8::Gemm g_{(const bf16_t*)(Aptr), (const bf16_t*)(Bptr), (Mrows), (N), (K)}; pg8::StaticOrder S_; S_.init((Mrows), (N), G, (int)blockIdx.x); \
        EPI E_{__VA_ARGS__}; pg8::gemm_phase<EPI, pg8::StaticOrder, ALIGN, true>(lds, g_, S_, E_); } while (0)

__global__ void __launch_bounds__(512, 2) fwd_megakernel(Params P) {
    extern __shared__ __attribute__((aligned(16))) unsigned char lds_raw[];
    LAS unsigned char* lds = (LAS unsigned char*)lds_raw;
    cg::grid_group grid = cg::this_grid();
    const int G = gridDim.x;
    unsigned char* ws = P.ws; float* X = P.out;
    bf16_t* XB = (bf16_t*)(ws + WS_XB); bf16_t* H = (bf16_t*)(ws + WS_H);
    float* ssq_q = (float*)(ws + WS_SSQQ); float* ssq_c = (float*)(ws + WS_SSQC);
    unsigned* ctl = (unsigned*)(ws + WS_CTL);
    for (int l = 0; l < DEPTH; ++l) {
#if (PHMASK >> 0) & 1
        convert_phase(P, l, lds, G);
#endif
        grid.sync();
#if (PHMASK >> 1) & 1
        PH_GEMM(EpiSwiglu, true, XB, ws + WS_W1A, M, 5632, 1024, H);
#endif
        grid.sync();
#if (PHMASK >> 2) & 1
        PH_GEMM(EpiResid, true, H, ws + WS_W2A, M, 1024, DFF, X, 0.5f);
#endif
        grid.sync();
#if (PHMASK >> 3) & 1
        ln_phase(X, XB, P.in[6] + l * D, P.in[7] + l * D, G);
#endif
        grid.sync();
#if (PHMASK >> 4) & 1
        PH_GEMM(EpiWin, true, XB, ws + WS_WIN, M, NIN, 1024, (bf16_t*)(ws + WS_ZQ), (bf16_t*)(ws + WS_KR), (bf16_t*)(ws + WS_QB), (bf16_t*)(ws + WS_KB), (bf16_t*)(ws + WS_VB),
                (bf16_t*)(ws + WS_GA), (bf16_t*)(ws + WS_GB), ssq_q, ssq_c, P.out, l);
#endif
        grid.sync();
#if (PHMASK >> 5) & 1
        ckv_phase(P.out, l, ssq_c, P.in[13] + l * 256, (bf16_t*)(ws + WS_CKVB), G);
#endif
        grid.sync();
#if (PHMASK >> 6) & 1
        PH_GEMM(EpiQ, true, ws + WS_ZQ, ws + WS_WUQ, M, 768, 768, (bf16_t*)(ws + WS_Q), ssq_q);
#endif
#if (PHMASK >> 7) & 1
        PH_GEMM(EpiPlain, true, ws + WS_CKVB, ws + WS_WUKV, MALL, 1024, 256, (bf16_t*)(ws + WS_KNV), 1024);
#endif
        grid.sync();
#if (PHMASK >> 8) & 1
        att::phase(ws, P.in[16] + (size_t)l * 8 * 257, ctl + 64 * l, lds);
#endif
        grid.sync();
#if (PHMASK >> 9) & 1
        PH_GEMM(EpiGate<0>, true, ws + WS_ZQ  , ws + WS_WPA, M, 1024, 512, (bf16_t*)(ws + WS_GA), nullptr);
#endif
#if (PHMASK >> 10) & 1
        PH_GEMM(EpiGate<1>, true, ws + WS_OB, ws + WS_WPB, M, 1024, 512, (bf16_t*)(ws + WS_GA), (const bf16_t*)(ws + WS_GB));
#endif
        grid.sync();
#if (PHMASK >> 11) & 1
        PH_GEMM(EpiResid, true, ws + WS_GA, ws + WS_WOUT, M, 1024, 1024, X, 1.0f);
#endif
        grid.sync();
#if (PHMASK >> 12) & 1
        ln_phase(X, XB, P.in[20] + l * D, P.in[21] + l * D, G);
#endif
        grid.sync();
#if (PHMASK >> 13) & 1
        PH_GEMM(EpiSwiglu, true, XB, ws + WS_W1B, M, 5632, 1024, H);
#endif
        grid.sync();
#if (PHMASK >> 14) & 1
        PH_GEMM(EpiResid, true, H, ws + WS_W2B, M, 1024, DFF, X, 0.5f);
#endif
        grid.sync();
#if (PHMASK >> 15) & 1
        ln_phase(X, XB, P.in[24] + l * D, P.in[25] + l * D, G);
#endif
        grid.sync();
    }
}

extern "C" void kernel_launch(void* const* d_in, const int* in_sizes, int n_in, void* d_out, int out_size, void* d_ws, size_t ws_size, hipStream_t stream) {
    static int grid = 0;
    if (grid == 0) {
        if (n_in != 26 || (size_t)out_size != O_END || ws_size < WS_END) { fprintf(stderr, "kernel_launch: unexpected sizes: n_in %d out %d (want %zu) ws %zu (need %zu)\n", n_in, out_size, (size_t)O_END, ws_size, (size_t)WS_END); grid = -1; return; }
        int dev = 0, cus = 0, per_cu = 0;
        hipGetDevice(&dev); hipDeviceGetAttribute(&cus, hipDeviceAttributeMultiprocessorCount, dev);
        if (hipFuncSetAttribute((const void*)fwd_megakernel, hipFuncAttributeMaxDynamicSharedMemorySize, LDS_BYTES) != hipSuccess) { fprintf(stderr, "kernel_launch: hipFuncSetAttribute failed\n"); grid = -1; return; }
        if (hipOccupancyMaxActiveBlocksPerMultiprocessor(&per_cu, (const void*)fwd_megakernel, 512, LDS_BYTES) != hipSuccess || per_cu < 1) { fprintf(stderr, "kernel_launch: occupancy query says %d\n", per_cu); per_cu = 1; }
        (void)hipGetLastError();
        grid = cus * per_cu;
    }
    if (grid < 0) return;
    hipMemsetAsync((char*)d_ws + WS_CTL, 0, 4096, stream);
    Params p{};
    for (int i = 0; i < 26; ++i) p.in[i] = (const float*)d_in[i];
    p.out = (float*)d_out; p.ws = (unsigned char*)d_ws;
    void* args[] = {&p};
    hipError_t e = hipLaunchCooperativeKernel((const void*)fwd_megakernel, dim3(grid), dim3(512), args, LDS_BYTES, stream);
    if (e != hipSuccess) fprintf(stderr, "cooperative launch failed: %s (grid %d)\n", hipGetErrorString(e), grid);
}
```

```cpp
#include <hip/hip_runtime.h>
#include <hip/hip_cooperative_groups.h>
#include <cstdio>
#include <cstdint>
namespace cg = cooperative_groups;
namespace pg8 {
#define PG8_LAS __attribute__((address_space(3)))
typedef unsigned short bf16_t;
typedef short bf16x8 __attribute__((ext_vector_type(8)));
typedef float f32x4 __attribute__((ext_vector_type(4)));
typedef unsigned u32x4 __attribute__((ext_vector_type(4)));
constexpr int BM = 256, BK = 64, HALF = 128, HTB = HALF * BK * 2  , STAGE_BYTES = 8 * HTB, NXCD = 8, WGM = 8;

__host__ __device__ __forceinline__ int lds_byte(int r, int c) { const int st = (r >> 4) * 2 + (c >> 5), rr = r & 15, cc = c & 31, ob = rr * 64 + cc * 2; return st * 1024 + (ob ^ (((ob >> 9) & 1) << 5)); }
__host__ __device__ __forceinline__ void stage_rc(int b, int& R, int& C) { const int st = b / 1024, sb = b % 1024, swz = sb ^ (((sb >> 9) & 1) << 5); R = (st >> 1) * 16 + swz / 64; C = (st & 1) * 32 + (swz % 64) / 2; }
__host__ __device__ __forceinline__ int perm32(int rho) { const int n = rho >> 4, i = rho & 15; return 8 * (i >> 2) + 4 * n + (i & 3); }

struct Unit { int pm, pn; };
struct Gemm { const bf16_t* A; const bf16_t* Bt; int M, N, K; };

struct StaticOrder {
    int nM, nN, nwg, G, c;
    __host__ __device__ void init(int M, int N, int G_, int c_) { nM = M / BM; nN = N / BM; nwg = nM * nN; G = G_; c = c_; }
    __host__ __device__ bool next(int i, Unit& u) const {
        const long L = (long)i * G + c; if (L >= nwg) return false;
        int wgid = (int)L; { const int q = nwg / NXCD, r = nwg % NXCD, xcd = wgid % NXCD, off = wgid / NXCD; wgid = (xcd < r ? xcd * (q + 1) : r * (q + 1) + (xcd - r) * q) + off; }
        const int nig = WGM * nN, gid = wgid / nig, fm = gid * WGM, gsz = (nM - fm) < WGM ? (nM - fm) : WGM;
        u.pm = fm + ((wgid % nig) % gsz); u.pn = (wgid % nig) / gsz; return true;
    }
    __device__ __forceinline__ void a_ready(const Unit&) const {}
    __device__ __forceinline__ void done(const Unit&) const {}
};

__device__ __forceinline__ unsigned cvt_pk_bf16(float lo, float hi) { unsigned r; asm volatile("v_cvt_pk_bf16_f32 %0, %1, %2" : "=v"(r) : "v"(lo), "v"(hi)); return r; }
typedef float f32x2 __attribute__((ext_vector_type(2)));
template <class Epi, class Sched, bool ALIGN_EPI = false, bool SP2 = false>
__device__ __forceinline__ void gemm_phase(PG8_LAS unsigned char* lds, const Gemm g, const Sched& S, const Epi& E) {
    int tid_ = threadIdx.x; asm volatile("" : "+v"(tid_)); const int tid = tid_, wid = __builtin_amdgcn_readfirstlane(tid >> 6), lane = tid & 63, wr = wid >> 2, wc = wid & 3, fr = lane & 15, fq = lane >> 4;
    int K_ = g.K; asm volatile("" : "+s"(K_)); const int K = K_, nt = K / BK;
    unsigned voffA[2], voffB[2];
#pragma unroll
    for (int i = 0; i < 2; ++i) { int R, C; stage_rc(tid * 16 + i * 8192, R, C); const int Rb = Epi::PERM ? ((R & ~31) + perm32(R & 31)) : R;
        voffA[i] = (unsigned)(R * K + C) * 2u; voffB[i] = (unsigned)(Rb * K + C) * 2u; }
    const size_t kstep = (size_t)(BK * 2);
    const size_t hstep = (size_t)HALF * K * 2;
    const size_t tstep = 2 * hstep;
    const unsigned ldsw = (unsigned)wid * 1024u;
    const int aoff = lds_byte(wr * 64 + fr, fq * 8), boff = lds_byte(wc * 32 + fr, fq * 8);
#define PG8_SA(b, h) (((b) * 2 + (h)) * HTB)
#define PG8_SB(b, h) ((4 + (b) * 2 + (h)) * HTB)
#define PG8_STAGE(bufoff, gbase, voff) do { _Pragma("unroll") for (int _i = 0; _i < 2; ++_i) \
        __builtin_amdgcn_global_load_lds((const unsigned*)((const char*)(gbase) + (voff)[_i]), (PG8_LAS unsigned*)(lds + (bufoff) + ldsw + _i * 8192), 16, 0, 0); } while (0)
#define PG8_LDA(dst, b, h) do { _Pragma("unroll") for (int m = 0; m < 4; ++m) _Pragma("unroll") for (int k = 0; k < 2; ++k) dst[m][k] = *(const PG8_LAS bf16x8*)(lds + PG8_SA(b, h) + aoff + m * 2048 + k * 1024); } while (0)
#define PG8_LDB(dst, b, h) do { _Pragma("unroll") for (int n = 0; n < 2; ++n) _Pragma("unroll") for (int k = 0; k < 2; ++k) dst[n][k] = *(const PG8_LAS bf16x8*)(lds + PG8_SB(b, h) + boff + n * 2048 + k * 1024); } while (0)
#define PG8_MMA(ai, bj, At, Bt) do { __builtin_amdgcn_s_setprio(1); _Pragma("unroll") for (int m = 0; m < 4; ++m) _Pragma("unroll") for (int n = 0; n < 2; ++n) _Pragma("unroll") for (int k = 0; k < 2; ++k) \
        acc[ai][bj][m][n] = __builtin_amdgcn_mfma_f32_16x16x32_bf16(Bt[n][k], At[m][k], acc[ai][bj][m][n], 0, 0, 0); __builtin_amdgcn_s_setprio(0); } while (0)
#define PG8_WAIT_V(n) asm volatile("s_waitcnt vmcnt(" #n ")" ::: "memory")
#define PG8_WAIT_L(n) asm volatile("s_waitcnt lgkmcnt(" #n ")" ::: "memory")
#define PG8_BAR __builtin_amdgcn_s_barrier()
#define PG8_SCHED __builtin_amdgcn_sched_barrier(0)
    Unit cur, nxt; int ui = 0;
    if (!S.next(0, cur)) return;
    f32x4 acc[2][2][4][2];
#pragma unroll
    for (int a = 0; a < 2; ++a)
#pragma unroll
        for (int b = 0; b < 2; ++b)
#pragma unroll
            for (int m = 0; m < 4; ++m)
#pragma unroll
                for (int n = 0; n < 2; ++n) acc[a][b][m][n] = (f32x4){0.f, 0.f, 0.f, 0.f};
    bf16x8 At[4][2], B0[2][2], B1[2][2];
    const char* cA = (const char*)g.A + (size_t)cur.pm * tstep; const char* cB = (const char*)g.Bt + (size_t)cur.pn * tstep;
    S.a_ready(cur);
    if constexpr (SP2) {
        PG8_STAGE(PG8_SB(0, 0), cB, voffB); PG8_STAGE(PG8_SB(0, 1), cB + hstep, voffB); PG8_STAGE(PG8_SA(0, 0), cA, voffA); PG8_STAGE(PG8_SA(0, 1), cA + hstep, voffA);
        if (wr == 1) PG8_BAR;
        PG8_WAIT_V(2); PG8_BAR;
        PG8_STAGE(PG8_SB(1, 0), cB + kstep, voffB); PG8_STAGE(PG8_SA(1, 0), cA + kstep, voffA); PG8_STAGE(PG8_SB(1, 1), cB + hstep + kstep, voffB);
        PG8_WAIT_V(6); PG8_BAR;
    } else {
        PG8_STAGE(PG8_SB(0, 0), cB, voffB); PG8_STAGE(PG8_SA(0, 0), cA, voffA); PG8_STAGE(PG8_SB(0, 1), cB + hstep, voffB); PG8_STAGE(PG8_SA(0, 1), cA + hstep, voffA);
        if (wr == 1) PG8_BAR;
        PG8_WAIT_V(4); PG8_BAR;
        PG8_STAGE(PG8_SB(1, 0), cB + kstep, voffB); PG8_STAGE(PG8_SA(1, 0), cA + kstep, voffA); PG8_STAGE(PG8_SB(1, 1), cB + hstep + kstep, voffB);
        PG8_WAIT_V(6); PG8_BAR;
    }
    for (;;) {
        const bool has_next = S.next(ui + 1, nxt);
        const char* nA = has_next ? (const char*)g.A + (size_t)nxt.pm * tstep : cA; const char* nB = has_next ? (const char*)g.Bt + (size_t)nxt.pn * tstep : cB;
        for (int t = 0; t < nt; t += 2) {
            const bool last = (t == nt - 2);
            const char* a1 = cA + (size_t)(t + 1) * kstep;
            const char* a2 = last ? nA : cA + (size_t)(t + 2) * kstep; const char* b2 = last ? nB : cB + (size_t)(t + 2) * kstep;
            const char* a3 = a2 + kstep; const char* b3 = b2 + kstep;
            if (last && has_next) S.a_ready(nxt);
            if constexpr (SP2) {
            PG8_LDB(B0, 0, 0); PG8_LDB(B1, 0, 1); PG8_SCHED; PG8_LDA(At, 0, 0); PG8_STAGE(PG8_SA(1, 1), a1 + hstep, voffA);
            PG8_WAIT_V(8); PG8_WAIT_L(0); PG8_BAR; PG8_MMA(0, 0, At, B0); PG8_MMA(0, 1, At, B1); PG8_BAR; PG8_SCHED;
            PG8_LDA(At, 0, 1); PG8_STAGE(PG8_SB(0, 0), b2, voffB); PG8_STAGE(PG8_SB(0, 1), b2 + hstep, voffB); PG8_STAGE(PG8_SA(0, 0), a2, voffA);
            PG8_WAIT_V(8); PG8_WAIT_L(0); PG8_BAR; PG8_MMA(1, 0, At, B0); PG8_MMA(1, 1, At, B1); PG8_BAR; PG8_SCHED;
            PG8_LDB(B0, 1, 0); PG8_LDB(B1, 1, 1); PG8_SCHED; PG8_LDA(At, 1, 0); PG8_STAGE(PG8_SA(0, 1), a2 + hstep, voffA);
            PG8_WAIT_V(8); PG8_WAIT_L(0); PG8_BAR; PG8_MMA(0, 0, At, B0); PG8_MMA(0, 1, At, B1); PG8_BAR; PG8_SCHED;
            PG8_LDA(At, 1, 1); PG8_STAGE(PG8_SB(1, 0), b3, voffB); PG8_STAGE(PG8_SB(1, 1), b3 + hstep, voffB); PG8_STAGE(PG8_SA(1, 0), a3, voffA);
            PG8_WAIT_V(8); PG8_WAIT_L(0); PG8_BAR; PG8_MMA(1, 0, At, B0); PG8_MMA(1, 1, At, B1); PG8_BAR; PG8_SCHED;
            } else {
            PG8_LDB(B0, 0, 0); PG8_SCHED; PG8_LDA(At, 0, 0); PG8_STAGE(PG8_SA(1, 1), a1 + hstep, voffA);
            PG8_WAIT_L(8); PG8_BAR; PG8_WAIT_L(0); PG8_MMA(0, 0, At, B0); PG8_BAR; PG8_SCHED;
            PG8_LDB(B1, 0, 1); PG8_STAGE(PG8_SB(0, 0), b2, voffB);
            PG8_BAR; PG8_WAIT_L(0); PG8_MMA(0, 1, At, B1); PG8_BAR;
            PG8_LDA(At, 0, 1); PG8_STAGE(PG8_SA(0, 0), a2, voffA);
            PG8_BAR; PG8_WAIT_L(0); PG8_MMA(1, 0, At, B0); PG8_BAR; PG8_SCHED;
            PG8_STAGE(PG8_SB(0, 1), b2 + hstep, voffB);
            PG8_WAIT_V(6); PG8_BAR; PG8_MMA(1, 1, At, B1); PG8_BAR;
            PG8_LDB(B0, 1, 0); PG8_SCHED; PG8_LDA(At, 1, 0); PG8_STAGE(PG8_SA(0, 1), a2 + hstep, voffA);
            PG8_WAIT_L(8); PG8_BAR; PG8_WAIT_L(0); PG8_MMA(0, 0, At, B0); PG8_BAR; PG8_SCHED;
            PG8_LDB(B1, 1, 1); PG8_STAGE(PG8_SB(1, 0), b3, voffB);
            PG8_BAR; PG8_WAIT_L(0); PG8_MMA(0, 1, At, B1); PG8_BAR;
            PG8_LDA(At, 1, 1); PG8_STAGE(PG8_SA(1, 0), a3, voffA);
            PG8_BAR; PG8_WAIT_L(0); PG8_MMA(1, 0, At, B0); PG8_BAR; PG8_SCHED;
            PG8_STAGE(PG8_SB(1, 1), b3 + hstep, voffB);
            PG8_WAIT_V(6); PG8_BAR; PG8_MMA(1, 1, At, B1); PG8_BAR;
            }
        }
        if constexpr (ALIGN_EPI) { if (wr == 0) PG8_BAR; }
        if constexpr (!Epi::AFTER_DRAIN) { E(acc, cur, wr, wc, fr, fq); S.done(cur); }
        if (!has_next) break;
#pragma unroll
        for (int a = 0; a < 2; ++a)
#pragma unroll
            for (int b = 0; b < 2; ++b)
#pragma unroll
                for (int m = 0; m < 4; ++m)
#pragma unroll
                    for (int n = 0; n < 2; ++n) acc[a][b][m][n] = (f32x4){0.f, 0.f, 0.f, 0.f};
        cur = nxt; cA = nA; cB = nB; ++ui;
        if constexpr (ALIGN_EPI) { if (wr == 1) PG8_BAR; }
    }
    PG8_WAIT_V(0);
    if constexpr (!ALIGN_EPI) { if (wr == 0) PG8_BAR; }
    PG8_BAR;
    if constexpr (Epi::AFTER_DRAIN) { E.fused(acc, cur, wr, wc, fr, fq, lds, wid, lane); S.done(cur); }
#undef PG8_SA
#undef PG8_SB
#undef PG8_STAGE
#undef PG8_LDA
#undef PG8_LDB
#undef PG8_MMA
#undef PG8_WAIT_V
#undef PG8_WAIT_L
#undef PG8_BAR
#undef PG8_SCHED
}
}

#define LAS __attribute__((address_space(3)))
typedef unsigned short bf16_t;
typedef short bf16x8 __attribute__((ext_vector_type(8)));
typedef short s16x4 __attribute__((ext_vector_type(4)));
typedef float f32x4 __attribute__((ext_vector_type(4)));
typedef float f32x16 __attribute__((ext_vector_type(16)));
typedef unsigned u32x4 __attribute__((ext_vector_type(4)));
typedef unsigned u32x2 __attribute__((ext_vector_type(2)));

constexpr int DEPTH = 4, MP = 32768, MS = 512, M = MP + MS, MC = 32768, MALL = M + MC;
constexpr int D = 1024, DFF = 2816, NIN = 4864, INC = 4640, MB = M + 4096;
constexpr float ALPHA = 1.681792830507429f, LOG2E = 1.4426950408889634f, EPS = 1e-5f;
constexpr float QS_MLA = 0.14724444602590306f, QS_BAND = 0.18033688011112042f;
__device__ const double INVREV[16] = {0.15915494309189535, 0.08949940160889101, 0.050329212104487035, 0.0283021958306234, 0.015915494309189534, 0.008949940160889102,
    0.005032921210448704, 0.00283021958306234, 0.0015915494309189536, 0.0008949940160889102, 0.0005032921210448703, 0.00028302195830623395, 0.00015915494309189535,
    8.949940160889102e-05, 5.0329212104487035e-05, 2.8302195830623396e-05};

constexpr size_t O_Y = 0, O_CKV_P = (size_t)M * D, O_KR_P = O_CKV_P + (size_t)DEPTH * MP * 256, O_BK_P = O_KR_P + (size_t)DEPTH * MP * 32,
    O_BV_P = O_BK_P + (size_t)DEPTH * 16 * 512 * 512, O_CKV_S = O_BV_P + (size_t)DEPTH * 16 * 512 * 512, O_KR_S = O_CKV_S + (size_t)DEPTH * MS * 256,
    O_BK_S = O_KR_S + (size_t)DEPTH * MS * 32, O_BV_S = O_BK_S + (size_t)DEPTH * MS * 512, O_END = O_BV_S + (size_t)DEPTH * MS * 512;

constexpr size_t al256(size_t x) { return (x + 255) & ~(size_t)255; }
constexpr size_t WS_CTL = 0, WS_SSQQ = 1u << 20, WS_SSQC = 3u << 20, WS_W = 4u << 20;
constexpr size_t SZ_W1 = (size_t)5632 * 1024 * 2, SZ_W2 = (size_t)1024 * 2816 * 2, SZ_WIN = (size_t)NIN * 1024 * 2, SZ_WUQ = (size_t)768 * 768 * 2, SZ_WUKV = (size_t)1024 * 256 * 2,
    SZ_WP = (size_t)1024 * 512 * 2, SZ_WO = (size_t)1024 * 1024 * 2;
constexpr size_t WS_W1A = WS_W, WS_W2A = WS_W1A + SZ_W1, WS_W1B = WS_W2A + SZ_W2, WS_W2B = WS_W1B + SZ_W1, WS_WIN = WS_W2B + SZ_W2, WS_WUQ = WS_WIN + SZ_WIN,
    WS_WUKV = WS_WUQ + SZ_WUQ, WS_WUKVG = WS_WUKV + SZ_WUKV, WS_WPA = WS_WUKVG + SZ_WUKV, WS_WPB = WS_WPA + SZ_WP, WS_WOUT = WS_WPB + SZ_WP, WS_WEND = WS_WOUT + SZ_WO;
constexpr size_t WSZ = al256(WS_WEND - WS_W);
constexpr size_t WS_XB = WS_W + 2 * WSZ, WS_ZQ = WS_XB + (size_t)M * D * 2  , WS_CKVB = WS_ZQ + (size_t)M * 768 * 2, WS_KR = WS_CKVB + (size_t)MALL * 256 * 2,
    WS_QB = WS_KR + (size_t)MALL * 32 * 2, WS_KB = WS_QB + (size_t)M * 512 * 2, WS_VB = WS_KB + (size_t)MB * 512 * 2, WS_KNV = WS_VB + (size_t)MB * 512 * 2,
    WS_OB = WS_KNV + (size_t)MALL * 1024 * 2, WS_H = WS_OB + (size_t)M * 512 * 2, WS_GA = WS_H, WS_GB = WS_GA + (size_t)M * D * 2, WS_Q = WS_GB + (size_t)M * D * 2,
    WS_END = WS_H + (size_t)M * DFF * 2;
static_assert(WS_Q + (size_t)M * 768 * 2 == WS_END, "H overlays GA|GB|Q exactly");

__device__ __forceinline__ unsigned cvtpk(float lo, float hi) { typedef float f2 __attribute__((ext_vector_type(2))); typedef __bf16 b2 __attribute__((ext_vector_type(2)));
    f2 v = {lo, hi}; b2 b = __builtin_convertvector(v, b2); return __builtin_bit_cast(unsigned, b); }
__device__ __forceinline__ u32x4 pack8(f32x4 a, f32x4 b) { u32x4 w; w.x = cvtpk(a[0], a[1]); w.y = cvtpk(a[2], a[3]); w.z = cvtpk(b[0], b[1]); w.w = cvtpk(b[2], b[3]); return w; }
__device__ __forceinline__ float bf2f(unsigned short h) { return __uint_as_float((unsigned)h << 16); }
__device__ __forceinline__ float sigmoidf_(float x) { return __builtin_amdgcn_rcpf(1.f + __expf(-x)); }
__device__ __forceinline__ int row_pos(int m) { return m < MP ? (m & 2047) : 4096 + ((m - MP) & 63); }
__device__ __forceinline__ void rope_cs(int pos, int i, float& c, float& s) { double rev = (double)pos * INVREV[i]; rev -= floor(rev); const float r = (float)rev; s = __builtin_amdgcn_sinf(r); c = __builtin_amdgcn_cosf(r); }

using pg8::Unit;
#define EPI_ARGS const f32x4 (&acc)[2][2][4][2], const Unit& u, int wr, int wc, int fr, int fq
#define FOR_AI_M _Pragma("unroll") for (int ai = 0; ai < 2; ++ai) _Pragma("unroll") for (int m = 0; m < 4; ++m)

struct EpiSwiglu { static constexpr bool PERM = true, AFTER_DRAIN = false; bf16_t* H;
    __device__ __forceinline__ void operator()(EPI_ARGS) const {
        const int row0 = u.pm * 256 + wr * 64 + fr, col0 = u.pn * 128 + wc * 32 + 8 * fq;
        FOR_AI_M { const int row = row0 + ai * 128 + m * 16; f32x4 h0, h1;
#pragma unroll
            for (int i = 0; i < 4; ++i) { const float a = acc[ai][0][m][0][i], b = acc[ai][0][m][1][i]; h0[i] = a * sigmoidf_(a) * acc[ai][1][m][0][i]; h1[i] = b * sigmoidf_(b) * acc[ai][1][m][1][i]; }
            *(u32x4*)(H + (size_t)row * DFF + col0) = pack8(h0, h1); }
    } };
struct EpiResid { static constexpr bool PERM = true, AFTER_DRAIN = false; float* X; float s;
    __device__ __forceinline__ void operator()(EPI_ARGS) const {
        const int row0 = u.pm * 256 + wr * 64 + fr, col0 = u.pn * 256 + wc * 32 + 8 * fq;
        FOR_AI_M { float* xp = X + (size_t)(row0 + ai * 128 + m * 16) * D + col0;
#pragma unroll
            for (int bj = 0; bj < 2; ++bj)
#pragma unroll
                for (int n = 0; n < 2; ++n) { f32x4* p = (f32x4*)(xp + bj * 128 + 4 * n); *p = *p * ALPHA + acc[ai][bj][m][n] * s; } }
    } };
struct EpiPlainRstd { static constexpr bool PERM = true, AFTER_DRAIN = false; bf16_t* O; const float* ssq_c;
    __device__ __forceinline__ void operator()(EPI_ARGS) const {
        const int row0 = u.pm * 256 + wr * 64 + fr, col0 = u.pn * 256 + wc * 32 + 8 * fq;
        FOR_AI_M { const int row = row0 + ai * 128 + m * 16; const f32x4 sp = *(const f32x4*)(ssq_c + (size_t)row * 4);
            const float rs = __builtin_amdgcn_rsqf(((sp[0] + sp[1]) + (sp[2] + sp[3])) * (1.f / 256.f) + EPS); bf16_t* op = O + (size_t)row * 1024 + col0;
#pragma unroll
            for (int bj = 0; bj < 2; ++bj) *(u32x4*)(op + bj * 128) = pack8(acc[ai][bj][m][0] * rs, acc[ai][bj][m][1] * rs); }
    } };
struct EpiPlain { static constexpr bool PERM = true, AFTER_DRAIN = false; bf16_t* O; int ldc;
    __device__ __forceinline__ void operator()(EPI_ARGS) const {
        const int row0 = u.pm * 256 + wr * 64 + fr, col0 = u.pn * 256 + wc * 32 + 8 * fq;
        FOR_AI_M { bf16_t* op = O + (size_t)(row0 + ai * 128 + m * 16) * ldc + col0;
#pragma unroll
            for (int bj = 0; bj < 2; ++bj) *(u32x4*)(op + bj * 128) = pack8(acc[ai][bj][m][0], acc[ai][bj][m][1]); }
    } };
template <int MODE> struct EpiGate { static constexpr bool PERM = true, AFTER_DRAIN = false; bf16_t* T; const bf16_t* G;
    __device__ __forceinline__ void operator()(EPI_ARGS) const {
        const int row0 = u.pm * 256 + wr * 64 + fr, col0 = u.pn * 256 + wc * 32 + 8 * fq;
        FOR_AI_M { const size_t off = (size_t)(row0 + ai * 128 + m * 16) * D + col0;
#pragma unroll
            for (int bj = 0; bj < 2; ++bj) { const bf16x8 t = *(const bf16x8*)(T + off + bj * 128); f32x4 r0, r1;
                if (MODE == 0) {
#pragma unroll
                    for (int i = 0; i < 4; ++i) { r0[i] = bf2f((unsigned short)t[i]) * acc[ai][bj][m][0][i]; r1[i] = bf2f((unsigned short)t[4 + i]) * acc[ai][bj][m][1][i]; }
                } else { const bf16x8 g = *(const bf16x8*)(G + off + bj * 128);
#pragma unroll
                    for (int i = 0; i < 4; ++i) { r0[i] = bf2f((unsigned short)t[i]) + bf2f((unsigned short)g[i]) * acc[ai][bj][m][0][i]; r1[i] = bf2f((unsigned short)t[4 + i]) + bf2f((unsigned short)g[4 + i]) * acc[ai][bj][m][1][i]; }
                }
                *(u32x4*)(T + off + bj * 128) = pack8(r0, r1); } }
    } };
struct EpiWin { static constexpr bool PERM = true, AFTER_DRAIN = false;
    bf16_t *ZQ, *KR, *QB, *KB, *VB, *GA, *GB, *CKVB; float *ssq_q, *ssq_c, *out; int layer;
    __device__ __forceinline__ void operator()(EPI_ARGS) const {
        const int pn = u.pn, row0 = u.pm * 256 + wr * 64 + fr, cw = wc * 32 + 8 * fq;
        const bool samp = u.pm >= 128;
        if (pn < 3) {
            FOR_AI_M { const int row = row0 + ai * 128 + m * 16; float ss = 0.f;
#pragma unroll
                for (int bj = 0; bj < 2; ++bj) { const f32x4 a = acc[ai][bj][m][0], b = acc[ai][bj][m][1]; ss += (a[0] * a[0] + a[1] * a[1]) + (a[2] * a[2] + a[3] * a[3]) + (b[0] * b[0] + b[1] * b[1]) + (b[2] * b[2] + b[3] * b[3]);
                    *(u32x4*)(ZQ + (size_t)row * 768 + pn * 256 + bj * 128 + cw) = pack8(a, b); }
                ss += __shfl_xor(ss, 16); ss += __shfl_xor(ss, 32);
                if (fq == 0) ssq_q[(size_t)row * 12 + pn * 4 + wc] = ss; }
        } else if (pn == 3) {
            FOR_AI_M { const int row = row0 + ai * 128 + m * 16; float ss = 0.f;
                float* op = samp ? out + O_CKV_S + ((size_t)layer * MS + (row - MP)) * 256 : out + O_CKV_P + ((size_t)layer * MP + row) * 256;
#pragma unroll
                for (int bj = 0; bj < 2; ++bj) { const f32x4 a = acc[ai][bj][m][0], b = acc[ai][bj][m][1]; ss += (a[0] * a[0] + a[1] * a[1]) + (a[2] * a[2] + a[3] * a[3]) + (b[0] * b[0] + b[1] * b[1]) + (b[2] * b[2] + b[3] * b[3]);
                    *(f32x4*)(op + bj * 128 + cw) = a; *(f32x4*)(op + bj * 128 + cw + 4) = b; *(u32x4*)(CKVB + (size_t)row * 256 + bj * 128 + cw) = pack8(a, b); }
                ss += __shfl_xor(ss, 16); ss += __shfl_xor(ss, 32);
                if (fq == 0) ssq_c[(size_t)row * 4 + wc] = ss; }
        } else if (pn == 4) {
            if (wc == 0) {
                FOR_AI_M { const int row = row0 + ai * 128 + m * 16, pos = row_pos(row);
                    float* op = samp ? out + O_KR_S + ((size_t)layer * MS + (row - MP)) * 32 : out + O_KR_P + ((size_t)layer * MP + row) * 32;
                    const f32x4 a = acc[ai][0][m][0], b = acc[ai][0][m][1]; const float v[8] = {a[0], a[1], a[2], a[3], b[0], b[1], b[2], b[3]}; float r[8];
#pragma unroll
                    for (int j = 0; j < 4; ++j) { const int i = 4 * fq + j; float c, s; rope_cs(pos, i, c, s); const float x1 = v[2 * j], x2 = v[2 * j + 1];
                        r[2 * j] = x1 * c - x2 * s; r[2 * j + 1] = x2 * c + x1 * s; op[i] = r[2 * j]; op[16 + i] = r[2 * j + 1]; }
                    *(u32x4*)(KR + (size_t)row * 32 + 8 * fq) = pack8((f32x4){r[0], r[1], r[2], r[3]}, (f32x4){r[4], r[5], r[6], r[7]}); }
            }
        } else if (pn < 7) {
            FOR_AI_M { const int row = row0 + ai * 128 + m * 16;
#pragma unroll
                for (int bj = 0; bj < 2; ++bj) *(u32x4*)(QB + (size_t)row * 512 + (pn - 5) * 256 + bj * 128 + cw) = pack8(acc[ai][bj][m][0] * QS_BAND, acc[ai][bj][m][1] * QS_BAND); }
        } else if (pn < 11) {
            const bool isv = pn >= 9; bf16_t* B = isv ? VB : KB; const int c0 = ((pn - 7) & 1) * 256 + cw;
            const bool wout = samp || ((u.pm & 7) >= 6);
            FOR_AI_M { const int row = row0 + ai * 128 + m * 16;
                float* op = samp ? out + (isv ? O_BV_S : O_BK_S) + ((size_t)layer * MS + (row - MP)) * 512
                                 : out + (isv ? O_BV_P : O_BK_P) + (((size_t)layer * 16 + (row >> 11)) * 512 + ((row & 2047) - 1536)) * 512;
#pragma unroll
                for (int bj = 0; bj < 2; ++bj) { const f32x4 a = acc[ai][bj][m][0], b = acc[ai][bj][m][1];
                    *(u32x4*)(B + (size_t)row * 512 + c0 + bj * 128) = pack8(a, b);
                    if (wout) { *(f32x4*)(op + c0 + bj * 128) = a; *(f32x4*)(op + c0 + bj * 128 + 4) = b; } } }
        } else {
            bf16_t* G = pn < 15 ? GA : GB; const int c0 = ((pn - 11) & 3) * 256 + cw;
            FOR_AI_M { const int row = row0 + ai * 128 + m * 16;
#pragma unroll
                for (int bj = 0; bj < 2; ++bj) { f32x4 a = acc[ai][bj][m][0], b = acc[ai][bj][m][1];
#pragma unroll
                    for (int i = 0; i < 4; ++i) { a[i] = sigmoidf_(a[i]); b[i] = sigmoidf_(b[i]); }
                    *(u32x4*)(G + (size_t)row * D + c0 + bj * 128) = pack8(a, b); } }
        }
    } };
struct EpiQ { static constexpr bool PERM = true, AFTER_DRAIN = false; bf16_t* Q; const float* ssq_q;
    __device__ __forceinline__ void operator()(EPI_ARGS) const {
        const int row0 = u.pm * 256 + wr * 64 + fr, col0 = u.pn * 256 + wc * 32 + 8 * fq;
        FOR_AI_M { const int row = row0 + ai * 128 + m * 16; const f32x4* sp = (const f32x4*)(ssq_q + (size_t)row * 12);
            const f32x4 s0 = sp[0], s1 = sp[1], s2 = sp[2];
            const float ss = ((s0[0] + s0[1]) + (s0[2] + s0[3])) + ((s1[0] + s1[1]) + (s1[2] + s1[3])) + ((s2[0] + s2[1]) + (s2[2] + s2[3]));
            const float sc = QS_MLA * __builtin_amdgcn_rsqf(ss * (1.0f / 768.0f) + EPS);
#pragma unroll
            for (int bj = 0; bj < 2; ++bj) { f32x4 a = acc[ai][bj][m][0] * sc, b = acc[ai][bj][m][1] * sc;
                const int cb = 8 * u.pn + 4 * bj + wc;
                if (cb % 3 == 2) { const int pos = row_pos(row); const float v[8] = {a[0], a[1], a[2], a[3], b[0], b[1], b[2], b[3]}; float r[8];
#pragma unroll
                    for (int j = 0; j < 4; ++j) { float c, s; rope_cs(pos, 4 * fq + j, c, s); r[2 * j] = v[2 * j] * c - v[2 * j + 1] * s; r[2 * j + 1] = v[2 * j + 1] * c + v[2 * j] * s; }
                    a = (f32x4){r[0], r[1], r[2], r[3]}; b = (f32x4){r[4], r[5], r[6], r[7]}; }
                *(u32x4*)(Q + (size_t)row * 768 + col0 + bj * 128) = pack8(a, b); } }
    } };
#define XB_TMO      128
#define XB_XCNT(j)  (256  + 64 * (j))
#define XB_XSUB(j)  (1280 + 64 * (j))
#define XB_XGEN(j)  (2304 + 64 * (j))
#define XB_TOP      3328
#define XB_TOPGEN   3392
#define XCD_BAR_WORDS 3456
#define XB_SPIN_CAP (1u << 18)

__device__ __forceinline__ unsigned xb_ld(unsigned* p)              { return __hip_atomic_load(p, __ATOMIC_RELAXED, __HIP_MEMORY_SCOPE_AGENT); }
__device__ __forceinline__ unsigned xb_add(unsigned* p, unsigned v) { return __hip_atomic_fetch_add(p, v, __ATOMIC_RELAXED, __HIP_MEMORY_SCOPE_AGENT); }
__device__ __forceinline__ unsigned xb_xcc_id() { return (unsigned)__builtin_amdgcn_s_getreg((3 << 11) | 20) & 0xFu; }
#define XB_SPIN(cond, bar) do { unsigned _sp = 0; while (cond) { __builtin_amdgcn_s_sleep(1); \
    if ((++_sp & 255u) == 0u) { if (xb_ld(&(bar)[XB_TMO])) break; if (_sp > XB_SPIN_CAP) { atomicAdd(&(bar)[XB_TMO], 1u); break; } } } } while (0)

struct XcdBarrier {
    unsigned* bar; unsigned x;
    volatile LAS unsigned* st;
};

__device__ __forceinline__ XcdBarrier xcd_barrier_post(unsigned* bar, volatile LAS unsigned* st) {
    XcdBarrier b; b.bar = bar; b.x = xb_xcc_id(); b.st = st;
    if (threadIdx.x == 0) (void)xb_add(&bar[XB_XCNT(b.x)], 1u);
    return b;
}
__device__ __forceinline__ void xcd_barrier_complete(unsigned* bar, unsigned x, unsigned& nloc, unsigned& nx) {
    const unsigned G = gridDim.x * gridDim.y * gridDim.z;
    unsigned sum, cnt, mine, sp = 0u;
    for (;;) {
        sum = 0u; cnt = 0u; mine = 0u;
#pragma unroll
        for (unsigned j = 0; j < 16; ++j) { const unsigned c = xb_ld(&bar[XB_XCNT(j)]); sum += c; cnt += (c > 0u) ? 1u : 0u; mine = (j == x) ? c : mine; }
        if (sum == G) break;
        __builtin_amdgcn_s_sleep(1);
        if ((++sp & 255u) == 0u) { if (xb_ld(&bar[XB_TMO])) break; if (sp > XB_SPIN_CAP) { atomicAdd(&bar[XB_TMO], 1u); break; } }
    }
    nloc = mine > 0u ? mine : 1u; nx = cnt > 0u ? cnt : 1u;
}

__device__ __forceinline__ void xcd_barrier(const XcdBarrier& b) {
    asm volatile("s_waitcnt vmcnt(0)" ::: "memory");
    __syncthreads();
    if (threadIdx.x == 0) {
        unsigned* bar = b.bar;
        __builtin_amdgcn_s_waitcnt(0);
        unsigned nloc = b.st[0], nx = b.st[1];
        if (nloc == 0u) { xcd_barrier_complete(bar, b.x, nloc, nx); b.st[0] = nloc; b.st[1] = nx; }
        const unsigned old = xb_add(&bar[XB_XSUB(b.x)], 1u);
        const unsigned gen = old / nloc;
        if (old + 1u == (gen + 1u) * nloc) {
            __builtin_amdgcn_fence(__ATOMIC_RELEASE, "agent");
            asm volatile("s_waitcnt vmcnt(0)" ::: "memory");
            const unsigned og = xb_add(&bar[XB_TOP], 1u);
            const unsigned tg = og / nx;
            if (og + 1u == (tg + 1u) * nx) xb_add(&bar[XB_TOPGEN], 1u);
            else XB_SPIN(xb_ld(&bar[XB_TOPGEN]) == tg, bar);
            __builtin_amdgcn_fence(__ATOMIC_ACQUIRE, "agent");
            xb_add(&bar[XB_XGEN(b.x)], 1u);
            asm volatile("s_waitcnt vmcnt(0)" ::: "memory");
        } else {
            XB_SPIN(xb_ld(&bar[XB_XGEN(b.x)]) == gen, bar);
            __builtin_amdgcn_fence(__ATOMIC_ACQUIRE, "agent");
            asm volatile("s_waitcnt vmcnt(0)" ::: "memory");
        }
    }
    __syncthreads();
}

#define LDS_WAIT() asm volatile("s_waitcnt lgkmcnt(0)" ::: "memory")
__device__ __forceinline__ void t_item(const float* src, int ldn, int K, int k0, int cbase, bool ilv, const float* kscale, bf16_t* dst, int n0, LAS float* scr, int lane) {
    const int c = lane & 7;
    if (cbase < 0) {
#pragma unroll
        for (int j = 0; j < 4; ++j) { const int n = (lane >> 3) + 8 * j; *(u32x4*)(dst + (size_t)(n0 + n) * K + k0 + 8 * c) = (u32x4){0u, 0u, 0u, 0u}; }
        return;
    }
#pragma unroll 8
    for (int i = 0; i < 32; ++i) { const int kk = 2 * i + (lane >> 5); float v = src[(size_t)(k0 + kk) * ldn + cbase + (lane & 31)]; if (kscale) v *= kscale[k0 + kk]; scr[kk * 33 + (lane & 31)] = v; }
    LDS_WAIT(); asm volatile("" ::: "memory");
#pragma unroll
    for (int j = 0; j < 4; ++j) { const int n = (lane >> 3) + 8 * j; const int sc = ilv ? ((n >> 1) + 16 * (n & 1)) : n; const LAS float* s = scr + (8 * c) * 33 + sc;
        u32x4 o; o.x = cvtpk(s[0 * 33], s[1 * 33]); o.y = cvtpk(s[2 * 33], s[3 * 33]); o.z = cvtpk(s[4 * 33], s[5 * 33]); o.w = cvtpk(s[6 * 33], s[7 * 33]);
        *(u32x4*)(dst + (size_t)(n0 + n) * K + k0 + 8 * c) = o; }
    LDS_WAIT(); asm volatile("" ::: "memory");
}
struct Params { const float* in[26]; float* out; unsigned char* ws; };
typedef const Params __attribute__((address_space(4)))* KP;
__device__ __forceinline__ KP kp_get() { KP p = (KP)__builtin_amdgcn_kernarg_segment_ptr(); asm volatile("" : "+s"(p)); return p; }
#define PIN(i) (kp_get()->in[i])

__device__ __forceinline__ void convert_phase(int l, LAS unsigned char* lds, int G) {
    unsigned char* const ws0 = kp_get()->ws; unsigned char* wsw = ws0 + (size_t)(l & 1) * WSZ;
    int tid_ = threadIdx.x; asm volatile("" : "+v"(tid_)); const int tid = tid_, lane = tid & 63, wave = tid >> 6;
    LAS float* scr = (LAS float*)(lds + wave * 8448);
    const int gw = blockIdx.x * 8 + wave, NGW = G * 8;
    unsigned char* ws = ws0;
    constexpr int I_W1 = 16 * 176, I_W2 = 44 * 32, I_WIN = 16 * 152, I_WUQ = 12 * 24, I_WUK = 4 * 16, I_WP = 8 * 32, I_WO = 16 * 32;
    constexpr int NITEMS = 2 * (I_W1 + I_W2) + I_WIN + I_WUQ + 4 * I_WUK + 2 * I_WP + I_WO;
    for (int it = gw; it < NITEMS; it += NGW) {
        int r = it;
#pragma unroll
        for (int f = 0; f < 2; ++f) {
            if (r >= 0 && r < I_W1) { const int kb = r / 176, nb = r % 176, n0 = nb * 32, t = n0 >> 8, j = n0 & 255; const int cb = j < 128 ? 128 * t + j : DFF + 128 * t + (j - 128);
                t_item(PIN(f ? 22 : 8) + (size_t)l * 1024 * 5632, 5632, 1024, kb * 64, cb, false, nullptr, (bf16_t*)(wsw + (f ? WS_W1B : WS_W1A)), n0, scr, lane); r = -1; }
            if (r >= 0) r -= I_W1;
            if (r >= 0 && r < I_W2) { const int kb = r / 32, nb = r % 32;
                t_item(PIN(f ? 23 : 9) + (size_t)l * 2816 * 1024, 1024, 2816, kb * 64, nb * 32, false, nullptr, (bf16_t*)(wsw + (f ? WS_W2B : WS_W2A)), nb * 32, scr, lane); r = -1; }
            if (r >= 0) r -= I_W2;
        }
        if (r < 0) continue;
        if (r < I_WIN) { const int kb = r / 152, nb = r % 152, n0 = nb * 32; int cb; bool il = false;
            if (n0 < 1024) cb = n0; else if (n0 == 1024) { cb = 1024; il = true; } else if (n0 < 1280) cb = -1; else cb = n0 - 1280 + 1056;
            t_item(PIN(10) + (size_t)l * 1024 * INC, INC, 1024, kb * 64, cb, il, nullptr, (bf16_t*)(wsw + WS_WIN), n0, scr, lane); continue; } r -= I_WIN;
        if (r < I_WUQ) { const int kb = r / 24, nb = r % 24;
            t_item(PIN(12) + (size_t)l * 768 * 768, 768, 768, kb * 64, nb * 32, (nb % 3) == 2, PIN(11) + l * 768, (bf16_t*)(wsw + WS_WUQ), nb * 32, scr, lane); continue; } r -= I_WUQ;
        if (r < I_WUK) { const int kb = r / 16, nb = r % 16; t_item(PIN(14) + (size_t)l * 256 * 512, 512, 256, kb * 64, nb * 32, false, nullptr, (bf16_t*)(wsw + WS_WUKV), nb * 32, scr, lane); continue; } r -= I_WUK;
        if (r < I_WUK) { const int kb = r / 16, nb = r % 16; t_item(PIN(15) + (size_t)l * 256 * 512, 512, 256, kb * 64, nb * 32, false, nullptr, (bf16_t*)(wsw + WS_WUKV), 512 + nb * 32, scr, lane); continue; } r -= I_WUK;
        if (r < I_WUK) { const int kb = r / 16, nb = r % 16; t_item(PIN(14) + (size_t)l * 256 * 512, 512, 256, kb * 64, nb * 32, false, PIN(13) + l * 256, (bf16_t*)(wsw + WS_WUKVG), nb * 32, scr, lane); continue; } r -= I_WUK;
        if (r < I_WUK) { const int kb = r / 16, nb = r % 16; t_item(PIN(15) + (size_t)l * 256 * 512, 512, 256, kb * 64, nb * 32, false, PIN(13) + l * 256, (bf16_t*)(wsw + WS_WUKVG), 512 + nb * 32, scr, lane); continue; } r -= I_WUK;
        if (r < I_WP) { const int kb = r / 32, nb = r % 32; t_item(PIN(17) + (size_t)l * 512 * 1024, 1024, 512, kb * 64, nb * 32, false, nullptr, (bf16_t*)(wsw + WS_WPA), nb * 32, scr, lane); continue; } r -= I_WP;
        if (r < I_WP) { const int kb = r / 32, nb = r % 32; t_item(PIN(18) + (size_t)l * 512 * 1024, 1024, 512, kb * 64, nb * 32, false, nullptr, (bf16_t*)(wsw + WS_WPB), nb * 32, scr, lane); continue; } r -= I_WP;
        { const int kb = r / 32, nb = r % 32; t_item(PIN(19) + (size_t)l * 1024 * 1024, 1024, 1024, kb * 64, nb * 32, false, nullptr, (bf16_t*)(wsw + WS_WOUT), nb * 32, scr, lane); }
    }
    const size_t gt = (size_t)blockIdx.x * 512 + tid, NT = (size_t)G * 512;
    { const f32x4* s = (const f32x4*)(PIN(2) + (size_t)l * MC * 256); u32x2* d = (u32x2*)((bf16_t*)(ws + WS_CKVB) + (size_t)M * 256);
      for (size_t i = gt; i < (size_t)MC * 64; i += NT) { const f32x4 v = s[i]; d[i] = (u32x2){cvtpk(v[0], v[1]), cvtpk(v[2], v[3])}; } }
    { const f32x4* s = (const f32x4*)(PIN(4) + (size_t)l * 4096 * 512); u32x2* d = (u32x2*)((bf16_t*)(ws + WS_KB) + (size_t)M * 512);
      for (size_t i = gt; i < (size_t)4096 * 128; i += NT) { const f32x4 v = s[i]; d[i] = (u32x2){cvtpk(v[0], v[1]), cvtpk(v[2], v[3])}; } }
    { const f32x4* s = (const f32x4*)(PIN(5) + (size_t)l * 4096 * 512); u32x2* d = (u32x2*)((bf16_t*)(ws + WS_VB) + (size_t)M * 512);
      for (size_t i = gt; i < (size_t)4096 * 128; i += NT) { const f32x4 v = s[i]; d[i] = (u32x2){cvtpk(v[0], v[1]), cvtpk(v[2], v[3])}; } }
    { const float* s = PIN(3) + (size_t)l * MC * 32; bf16_t* d = (bf16_t*)(ws + WS_KR) + (size_t)M * 32;
      for (size_t i = gt; i < (size_t)MC * 4; i += NT) { const size_t row = i >> 2; const int c = (int)(i & 3); const f32x4 a = *(const f32x4*)(s + row * 32 + 4 * c), b = *(const f32x4*)(s + row * 32 + 16 + 4 * c);
          *(u32x4*)(d + row * 32 + 8 * c) = (u32x4){cvtpk(a[0], b[0]), cvtpk(a[1], b[1]), cvtpk(a[2], b[2]), cvtpk(a[3], b[3])}; } }
    if (l == 0) {
        f32x4* X = (f32x4*)kp_get()->out; u32x2* XB = (u32x2*)(ws + WS_XB); const f32x4* xp = (const f32x4*)PIN(0); const f32x4* xs = (const f32x4*)PIN(1);
        for (size_t i = gt; i < (size_t)M * 256; i += NT) { const f32x4 v = i < (size_t)MP * 256 ? xp[i] : xs[i - (size_t)MP * 256]; X[i] = v; XB[i] = (u32x2){cvtpk(v[0], v[1]), cvtpk(v[2], v[3])}; }
    }
}

__device__ __forceinline__ float wave_sum(float v) {
#pragma unroll
    for (int o = 1; o < 64; o <<= 1) v += __shfl_xor(v, o);
    return v;
}
__device__ __forceinline__ void ln_phase(const float* X, const bf16_t*, const float* g, const float* b, int G, float* XO, bf16_t* XBO) {
    int tid_ = threadIdx.x; asm volatile("" : "+v"(tid_)); const int lane = tid_ & 63, gw = blockIdx.x * 8 + (tid_ >> 6), NGW = G * 8;
    f32x4 gv[4], bv[4];
#pragma unroll
    for (int j = 0; j < 4; ++j) { gv[j] = ((const f32x4*)g)[lane + 64 * j]; bv[j] = ((const f32x4*)b)[lane + 64 * j]; }
    for (int m = gw; m < M; m += NGW) {
        const f32x4* xr = (const f32x4*)(X + (size_t)m * D) + lane; f32x4* xo = (f32x4*)(XO + (size_t)m * D) + lane; f32x4 v[4]; float s = 0.f;
#pragma unroll
        for (int j = 0; j < 4; ++j) { v[j] = xr[64 * j]; s += (v[j][0] + v[j][1]) + (v[j][2] + v[j][3]); }
        const float mean = wave_sum(s) * (1.f / D); float s2 = 0.f;
#pragma unroll
        for (int j = 0; j < 4; ++j) { v[j] = v[j] - mean; s2 += (v[j][0] * v[j][0] + v[j][1] * v[j][1]) + (v[j][2] * v[j][2] + v[j][3] * v[j][3]); }
        const float rstd = 1.f / sqrtf(wave_sum(s2) * (1.f / D) + EPS);
        u32x2* o8 = (u32x2*)(XBO + (size_t)m * D) + lane;
#pragma unroll
        for (int j = 0; j < 4; ++j) { const f32x4 y = v[j] * rstd * gv[j] + bv[j]; xo[64 * j] = y; o8[64 * j] = (u32x2){cvtpk(y[0], y[1]), cvtpk(y[2], y[3])}; }
    }
}
__device__ __forceinline__ void ckv_phase(float* out, int l, const float* ssq_c, const float* g, int G) {
    int tid_ = threadIdx.x; asm volatile("" : "+v"(tid_)); const int lane = tid_ & 63, gw = blockIdx.x * 8 + (tid_ >> 6), NGW = G * 8;
    const f32x4 gv = ((const f32x4*)g)[lane];
    for (int m = gw; m < M; m += NGW) {
        float* op = m >= MP ? out + O_CKV_S + ((size_t)l * MS + (m - MP)) * 256 : out + O_CKV_P + ((size_t)l * MP + m) * 256;
        const f32x4 sp = *(const f32x4*)(ssq_c + (size_t)m * 4); const float rstd = __builtin_amdgcn_rsqf(((sp[0] + sp[1]) + (sp[2] + sp[3])) * (1.f / 256.f) + EPS);
        f32x4 v = ((f32x4*)op)[lane]; v = v * rstd * gv; ((f32x4*)op)[lane] = v;
    }
}

namespace att {
constexpr int KSTR = 208, L_K = 0, L_V = 2 * 64 * KSTR, L_TAB = L_V + 2 * 8192, L_Q = L_TAB + 1040, L_END = L_Q + 16;
struct Desc { int type, h, qrow0, nqc, c0, t_lo, t_hi, tc, cbase, nbase; };
__device__ __forceinline__ int crow(int r, int hi) { return (r & 3) + 8 * (r >> 2) + 4 * hi; }
__device__ __forceinline__ float xmax(float m) { auto rr = __builtin_amdgcn_permlane32_swap(__float_as_uint(m), __float_as_uint(m), false, false); return fmaxf(__uint_as_float(rr[0]), __uint_as_float(rr[1])); }
__device__ __forceinline__ float xsum(float m) { auto rr = __builtin_amdgcn_permlane32_swap(__float_as_uint(m), __float_as_uint(m), false, false); return __uint_as_float(rr[0]) + __uint_as_float(rr[1]); }
typedef short v4i16_t __attribute__((ext_vector_type(4)));
__device__ __forceinline__ s16x4 vtr(const LAS unsigned char* p) { return __builtin_bit_cast(s16x4, __builtin_amdgcn_ds_read_tr16_b64_v4i16((LAS v4i16_t*)p)); }

template <int TYPE>
__device__ __forceinline__ void unit(const Desc u, const bf16_t* Qp, int qld, const bf16_t* Kp, int kld, const bf16_t* Vp, int vld, const bf16_t* KRp, const float* tab_g, bf16_t* Op, LAS unsigned char* lds) {
    constexpr int NS = TYPE == 0 ? 6 : 4;
    int tid_ = threadIdx.x; asm volatile("" : "+v"(tid_)); const int tid = tid_, lane = tid & 63, w = __builtin_amdgcn_readfirstlane(tid >> 6), r32 = lane & 31, hi = lane >> 5;
    const bool wact = (w >> 1) < u.nqc; const int cw = u.c0 + (w >> 1);
    const int skey = tid >> 3, sch = tid & 7, rkey = (tid >> 2) & 63, rch = tid & 3;
    LAS float* tab = (LAS float*)(lds + L_TAB);
    if (TYPE == 1) { for (int i = tid; i < 257; i += 512) tab[i] = tab_g[i] * LOG2E; }
    const int qrow = u.qrow0 + 32 * w + r32;
    bf16x8 qf[NS];
    if (wact) {
#pragma unroll
        for (int s = 0; s < NS; ++s) qf[s] = *(const bf16x8*)(Qp + (size_t)qrow * qld + 16 * s + 8 * hi);
    }
    u32x4 kreg, vreg, rreg = (u32x4){0u, 0u, 0u, 0u};
#define ATT_LOADG(t) do { const int row_ = ((t) < u.tc) ? u.cbase + 64 * (t) : u.nbase + 64 * ((t) - u.tc); \
        kreg = *(const u32x4*)(Kp + (size_t)(row_ + skey) * kld + sch * 8); vreg = *(const u32x4*)(Vp + (size_t)(row_ + skey) * vld + sch * 8); \
        if (TYPE == 0 && tid < 256) rreg = *(const u32x4*)(KRp + (size_t)(row_ + rkey) * 32 + rch * 8); } while (0)
#define ATT_STOREL(b) do { *(LAS u32x4*)(lds + L_K + (b) * 64 * KSTR + skey * KSTR + sch * 16) = kreg; \
        *(LAS u32x4*)(lds + L_V + (b) * 8192 + ((skey >> 3) * 2 + (sch >> 2)) * 512 + (skey & 7) * 64 + (sch & 3) * 16) = vreg; \
        if (TYPE == 0 && tid < 256) *(LAS u32x4*)(lds + L_K + (b) * 64 * KSTR + rkey * KSTR + 128 + rch * 16) = rreg; } while (0)
    float m_run = -1e30f, l_run = 0.f; f32x16 o0 = {}, o1 = {};
    const int vlane = (4 * hi + ((lane >> 2) & 3)) * 64 + ((lane >> 4) & 1) * 32 + (lane & 3) * 8;
    ATT_LOADG(u.t_lo); ATT_STOREL(0); __syncthreads();
    for (int t = u.t_lo; t <= u.t_hi; ++t) {
        const int buf = (t - u.t_lo) & 1;
        if (t < u.t_hi) ATT_LOADG(t + 1);
        if (wact && t <= cw && (TYPE == 0 || t >= cw - 8)) {
            const LAS unsigned char* Kb = lds + L_K + buf * 64 * KSTR + r32 * KSTR + hi * 16;
            f32x16 p0 = {}, p1 = {};
#pragma unroll
            for (int s = 0; s < NS; ++s) { const bf16x8 k0 = *(const LAS bf16x8*)(Kb + s * 32), k1 = *(const LAS bf16x8*)(Kb + 32 * KSTR + s * 32);
                p0 = __builtin_amdgcn_mfma_f32_32x32x16_bf16(k0, qf[s], p0, 0, 0, 0); p1 = __builtin_amdgcn_mfma_f32_32x32x16_bf16(k1, qf[s], p1, 0, 0, 0); }
            if (TYPE == 1) { const int dc = cw - t;
                if (dc >= 3) { const float c = tab[256];
#pragma unroll
                    for (int r = 0; r < 16; ++r) { p0[r] += c; p1[r] += c; } }
                else { const int base = dc * 64 + (w & 1) * 32 + r32 + 128;
#pragma unroll
                    for (int r = 0; r < 16; ++r) { const int i0 = base - crow(r, hi), i1 = i0 - 32; p0[r] += tab[min(max(i0, 0), 256)]; p1[r] += tab[min(max(i1, 0), 256)]; } } }
            float mx = fmaxf(p0[0], p1[0]);
#pragma unroll
            for (int r = 1; r < 16; ++r) mx = fmaxf(mx, fmaxf(p0[r], p1[r]));
            mx = xmax(mx);
            const float mn = fmaxf(m_run, mx), alpha = __builtin_amdgcn_exp2f(m_run - mn); m_run = mn;
            float sum = 0.f;
#pragma unroll
            for (int r = 0; r < 16; ++r) { p0[r] = __builtin_amdgcn_exp2f(p0[r] - mn); p1[r] = __builtin_amdgcn_exp2f(p1[r] - mn); sum += p0[r] + p1[r]; }
            l_run = l_run * alpha + sum;
#pragma unroll
            for (int r = 0; r < 16; ++r) { o0[r] *= alpha; o1[r] *= alpha; }
            bf16x8 pf[2][2];
#pragma unroll
            for (int a = 0; a < 2; ++a) {
                pf[0][a] = __builtin_bit_cast(bf16x8, (u32x4){cvtpk(p0[8 * a], p0[8 * a + 1]), cvtpk(p0[8 * a + 2], p0[8 * a + 3]), cvtpk(p0[8 * a + 4], p0[8 * a + 5]), cvtpk(p0[8 * a + 6], p0[8 * a + 7])});
                pf[1][a] = __builtin_bit_cast(bf16x8, (u32x4){cvtpk(p1[8 * a], p1[8 * a + 1]), cvtpk(p1[8 * a + 2], p1[8 * a + 3]), cvtpk(p1[8 * a + 4], p1[8 * a + 5]), cvtpk(p1[8 * a + 6], p1[8 * a + 7])}); }
            const LAS unsigned char* Vb = lds + L_V + buf * 8192 + vlane;
#pragma unroll
            for (int kh = 0; kh < 2; ++kh)
#pragma unroll
                for (int a = 0; a < 2; ++a) {
                    { const s16x4 lo = vtr(Vb + (8 * kh + 4 * a) * 512), h4 = vtr(Vb + (8 * kh + 4 * a) * 512 + 1024);
                      const bf16x8 vf = (bf16x8){lo[0], lo[1], lo[2], lo[3], h4[0], h4[1], h4[2], h4[3]}; o0 = __builtin_amdgcn_mfma_f32_32x32x16_bf16(vf, pf[kh][a], o0, 0, 0, 0); }
                    { const s16x4 lo = vtr(Vb + (8 * kh + 4 * a + 1) * 512), h4 = vtr(Vb + (8 * kh + 4 * a + 1) * 512 + 1024);
                      const bf16x8 vf = (bf16x8){lo[0], lo[1], lo[2], lo[3], h4[0], h4[1], h4[2], h4[3]}; o1 = __builtin_amdgcn_mfma_f32_32x32x16_bf16(vf, pf[kh][a], o1, 0, 0, 0); }
                }
        }
        if (t < u.t_hi) ATT_STOREL(buf ^ 1);
        __syncthreads();
    }
    if (wact) {
        const float inv = 1.0f / xsum(l_run);
        bf16_t* op = Op + (size_t)qrow * 512;
#pragma unroll
        for (int g = 0; g < 4; ++g) {
            *(u32x2*)(op + 8 * g + 4 * hi) = (u32x2){cvtpk(o0[4 * g] * inv, o0[4 * g + 1] * inv), cvtpk(o0[4 * g + 2] * inv, o0[4 * g + 3] * inv)};
            *(u32x2*)(op + 32 + 8 * g + 4 * hi) = (u32x2){cvtpk(o1[4 * g] * inv, o1[4 * g + 1] * inv), cvtpk(o1[4 * g + 2] * inv, o1[4 * g + 3] * inv)}; }
    }
#undef ATT_LOADG
#undef ATT_STOREL
}

constexpr int NU_SM = 64, NU_A = 640, NU_B = 768, NU_C = 128, NU_D = 64, NU_E = 512, NUNITS = NU_SM + NU_A + NU_B + NU_C + NU_D + NU_E;
__device__ __forceinline__ Desc decode(int idx) {
    Desc d; int type, b, h, qb = 0; bool samp = false;
    if (idx < NU_SM) { type = 0; samp = true; b = idx >> 3; h = idx & 7; }
    else { idx -= NU_SM;
        if (idx < NU_A) { type = 0; qb = 7 - idx / 128; b = (idx % 128) >> 3; h = idx & 7; }
        else { idx -= NU_A;
            if (idx < NU_B) { type = 1; qb = 7 - idx / 128; b = (idx % 128) >> 3; h = idx & 7; }
            else { idx -= NU_B;
                if (idx < NU_C) { type = 0; qb = 2; b = idx >> 3; h = idx & 7; }
                else { idx -= NU_C;
                    if (idx < NU_D) { type = 1; samp = true; b = idx >> 3; h = idx & 7; }
                    else { idx -= NU_D; const int s = idx / 128; type = (s & 1) ? 0 : 1; qb = s < 2 ? 1 : 0; b = (idx % 128) >> 3; h = idx & 7; } } } } }
    d.type = type; d.h = h;
    if (samp) { d.qrow0 = MP + 64 * b; d.nqc = 1; d.t_lo = 0; d.nbase = MP + 64 * b;
        if (type == 0) { d.c0 = 64; d.t_hi = 64; d.tc = 64; d.cbase = M + 4096 * b; } else { d.c0 = 8; d.t_hi = 8; d.tc = 8; d.cbase = M + 512 * b; } }
    else { d.qrow0 = b * 2048 + 256 * qb; d.nqc = 4; d.c0 = 4 * qb; d.t_hi = 4 * qb + 3; d.tc = 0; d.cbase = 0; d.nbase = b * 2048; d.t_lo = type == 0 ? 0 : max(0, 4 * qb - 8); }
    return d;
}
__device__ __forceinline__ void phase(unsigned char* ws, const float* relb  , unsigned* ctr, LAS unsigned char* lds) {
    int tid_ = threadIdx.x; asm volatile("" : "+v"(tid_)); const int tid = tid_; LAS int* sq = (LAS int*)(lds + L_Q);
    const bf16_t* Q = (const bf16_t*)(ws + WS_Q); const bf16_t* KNV = (const bf16_t*)(ws + WS_KNV); const bf16_t* KR = (const bf16_t*)(ws + WS_KR);
    const bf16_t* QB = (const bf16_t*)(ws + WS_QB); const bf16_t* KB = (const bf16_t*)(ws + WS_KB); const bf16_t* VB = (const bf16_t*)(ws + WS_VB);
    bf16_t* OA = (bf16_t*)(ws + WS_ZQ); bf16_t* OB = (bf16_t*)(ws + WS_OB);
    for (;;) {
        if (tid == 0) *sq = (int)atomicAdd(ctr, 1u);
        __syncthreads(); const int idx = __builtin_amdgcn_readfirstlane(*sq); __syncthreads();
        if (idx >= NUNITS) break;
        const Desc d = decode(idx);
        if (d.type == 0) unit<0>(d, Q + d.h * 96, 768, KNV + d.h * 64, 1024, KNV + 512 + d.h * 64, 1024, KR, nullptr, OA + d.h * 64, lds);
        else unit<1>(d, QB + d.h * 64, 512, KB + d.h * 64, 512, VB + d.h * 64, 512, nullptr, relb + d.h * 257, OB + d.h * 64, lds);
    }
}
}
#ifndef PROBE_ATT
#define PROBE_ATT 0
#endif
#ifndef PROBE_UP
#define PROBE_UP 0
#endif
#ifndef PROBE_SYNC
#define PROBE_SYNC 0
#endif
#ifndef PROBE_LN
#define PROBE_LN 0
#endif
#ifndef PHMASK
#define PHMASK 0xFFFFFF
#endif

constexpr int LDS_BYTES = 147456;
#define PH_GEMM(EPI, ALIGN, Aptr, Bptr, Mrows, N, K, ...) do { pg8::Gemm g_{(const bf16_t*)(Aptr), (const bf16_t*)(Bptr), (Mrows), (N), (K)}; pg8::StaticOrder S_; S_.init((Mrows), (N), G, (int)blockIdx.x); \
        EPI E_{__VA_ARGS__}; pg8::gemm_phase<EPI, pg8::StaticOrder, ALIGN, true>(lds, g_, S_, E_); } while (0)

__global__ void __launch_bounds__(512, 2) fwd_megakernel(Params P) {
    extern __shared__ __attribute__((aligned(16))) unsigned char lds_raw[];
    LAS unsigned char* lds = (LAS unsigned char*)lds_raw;
    cg::grid_group grid = cg::this_grid();
    const int G = gridDim.x;
    unsigned char* ws = kp_get()->ws; float* X = kp_get()->out;
    bf16_t* XB = (bf16_t*)(ws + WS_XB); bf16_t* H = (bf16_t*)(ws + WS_H);
    float* ssq_q = (float*)(ws + WS_SSQQ); float* ssq_c = (float*)(ws + WS_SSQC);
    unsigned* ctl = (unsigned*)(ws + WS_CTL);
    volatile LAS unsigned* MISC = (volatile LAS unsigned*)(lds + LDS_BYTES - 64);
    if (threadIdx.x < 16) MISC[threadIdx.x] = 0u;
    __syncthreads();
    XcdBarrier bar = xcd_barrier_post(ctl + 4096, MISC);
    grid.sync();
#define GSYNC() xcd_barrier(bar)
    for (int l = 0; l <= DEPTH; ++l) {
        if (l > 0) ln_phase(X, XB, PIN(24) + (l - 1) * D, PIN(25) + (l - 1) * D, G, X, XB);
        if (l < DEPTH) convert_phase(l, lds, G);
        GSYNC();
        if (l == DEPTH) break;
        unsigned char* wsw = ws + (size_t)(l & 1) * WSZ;
        PH_GEMM(EpiPlain, true, ws + WS_CKVB + (size_t)M * 256 * 2, wsw + WS_WUKV, MC, 1024, 256, (bf16_t*)(ws + WS_KNV) + (size_t)M * 1024, 1024);
        PH_GEMM(EpiSwiglu, true, XB, wsw + WS_W1A, M, 5632, 1024, H);
        for (int rep_ = 0; rep_ < PROBE_UP; ++rep_) { GSYNC(); PH_GEMM(EpiSwiglu, true, XB, wsw + WS_W1A, M, 5632, 1024, H); }
        GSYNC();
        PH_GEMM(EpiResid, true, H, wsw + WS_W2A, M, 1024, DFF, X, 0.5f);
        GSYNC();
        for (int rep_ = 0; rep_ < PROBE_LN; ++rep_) { ln_phase(X, XB, PIN(6) + l * D, PIN(7) + l * D, G, (float*)(ws + WS_H), (bf16_t*)(ws + WS_H + (size_t)M * D * 4)); GSYNC(); }
        ln_phase(X, XB, PIN(6) + l * D, PIN(7) + l * D, G, X, XB);
        for (int rep_ = 0; rep_ < PROBE_SYNC; ++rep_) GSYNC();
        GSYNC();
        PH_GEMM(EpiWin, true, XB, wsw + WS_WIN, M, NIN, 1024, (bf16_t*)(ws + WS_ZQ), (bf16_t*)(ws + WS_KR), (bf16_t*)(ws + WS_QB), (bf16_t*)(ws + WS_KB), (bf16_t*)(ws + WS_VB),
                (bf16_t*)(ws + WS_GA), (bf16_t*)(ws + WS_GB), (bf16_t*)(ws + WS_CKVB), ssq_q, ssq_c, X, l);
        GSYNC();
        ckv_phase(X, l, ssq_c, PIN(13) + l * 256, G);
        PH_GEMM(EpiQ, true, ws + WS_ZQ, wsw + WS_WUQ, M, 768, 768, (bf16_t*)(ws + WS_Q), ssq_q);
        PH_GEMM(EpiPlainRstd, true, ws + WS_CKVB, wsw + WS_WUKVG, M, 1024, 256, (bf16_t*)(ws + WS_KNV), ssq_c);
        GSYNC();
        att::phase(ws, PIN(16) + (size_t)l * 8 * 257, ctl + 64 * l, lds);
        for (int rep_ = 0; rep_ < PROBE_ATT; ++rep_) { GSYNC(); att::phase(ws, PIN(16) + (size_t)l * 8 * 257, ctl + 64 * l + 16 * (rep_ + 1), lds); }
        GSYNC();
        PH_GEMM(EpiGate<0>, true, ws + WS_ZQ  , wsw + WS_WPA, M, 1024, 512, (bf16_t*)(ws + WS_GA), nullptr);
        PH_GEMM(EpiGate<1>, true, ws + WS_OB, wsw + WS_WPB, M, 1024, 512, (bf16_t*)(ws + WS_GA), (const bf16_t*)(ws + WS_GB));
        GSYNC();
        PH_GEMM(EpiResid, true, ws + WS_GA, wsw + WS_WOUT, M, 1024, 1024, X, 1.0f);
        GSYNC();
        ln_phase(X, XB, PIN(20) + l * D, PIN(21) + l * D, G, X, XB);
        GSYNC();
        PH_GEMM(EpiSwiglu, true, XB, wsw + WS_W1B, M, 5632, 1024, H);
        GSYNC();
        PH_GEMM(EpiResid, true, H, wsw + WS_W2B, M, 1024, DFF, X, 0.5f);
        GSYNC();
    }
}

extern "C" void kernel_launch(void* const* d_in, const int* in_sizes, int n_in, void* d_out, int out_size, void* d_ws, size_t ws_size, hipStream_t stream) {
    static int grid = 0;
    if (grid == 0) {
        if (n_in != 26 || (size_t)out_size != O_END || ws_size < WS_END) { fprintf(stderr, "kernel_launch: unexpected sizes: n_in %d out %d (want %zu) ws %zu (need %zu)\n", n_in, out_size, (size_t)O_END, ws_size, (size_t)WS_END); grid = -1; return; }
        int dev = 0, cus = 0, per_cu = 0;
        (void)hipGetDevice(&dev); (void)hipDeviceGetAttribute(&cus, hipDeviceAttributeMultiprocessorCount, dev);
        if (hipFuncSetAttribute((const void*)fwd_megakernel, hipFuncAttributeMaxDynamicSharedMemorySize, LDS_BYTES) != hipSuccess) { fprintf(stderr, "kernel_launch: hipFuncSetAttribute failed\n"); grid = -1; return; }
        if (hipOccupancyMaxActiveBlocksPerMultiprocessor(&per_cu, (const void*)fwd_megakernel, 512, LDS_BYTES) != hipSuccess || per_cu < 1) { fprintf(stderr, "kernel_launch: occupancy query says %d\n", per_cu); per_cu = 1; }
        (void)hipGetLastError();
        grid = cus * per_cu;
    }
    if (grid < 0) return;
    (void)hipMemsetAsync((char*)d_ws + WS_CTL, 0, 65536, stream);
    Params p{};
    for (int i = 0; i < 26; ++i) p.in[i] = (const float*)d_in[i];
    p.out = (float*)d_out; p.ws = (unsigned char*)d_ws;
    void* args[] = {&p};
    hipError_t e = hipLaunchCooperativeKernel((const void*)fwd_megakernel, dim3(grid), dim3(512), args, LDS_BYTES, stream);
    if (e != hipSuccess) fprintf(stderr, "cooperative launch failed: %s (grid %d)\n", hipGetErrorString(e), grid);
}
```
